# Optimizing an MI355X kernel written in HIP

```python
import jax, jax.numpy as jnp
from jax import lax
import numpy as np

D_MODEL = 2048
BATCH = 8
SEQ = 2048
DEPTH = 2

CTX_LEN = 256
GRID_W = 64
EPS = 1e-6

CHUNK = 128
GMLP_GROUPS = 8
W_A = D_MODEL // 2
GMLP_GW = W_A // GMLP_GROUPS

W_B = D_MODEL // 2
F_GROUPS = 4
F_GW = W_B // F_GROUPS

HEAD_DIM = 128
NA_HEADS = 8
W_C = NA_HEADS * HEAD_DIM
NA_KH = 8
NA_KW = 16
NA_BAND = 2 * NA_KW

OFF_U = 0
OFF_VG = OFF_U + W_A
OFF_GA = OFF_VG + W_A
OFF_F = OFF_GA + W_A
OFF_GF = OFF_F + W_B
OFF_Q = OFF_GF + W_B
OFF_K = OFF_Q + W_C
OFF_V = OFF_K + W_C
OFF_GN = OFF_V + W_C
OFF_MERGE = OFF_GN + W_C
W_IN = OFF_MERGE + 3 * D_MODEL

kernel_name = "hybrid_gmlp_fnet_natten_prefix_block"


def rms_norm(x, g):
    xf = x.astype(jnp.float32)
    y = xf * lax.rsqrt(jnp.mean(xf * xf, axis=-1, keepdims=True) + EPS)
    return (y * g.astype(jnp.float32)).astype(x.dtype)


def layer_norm(x, g, b):
    xf = x.astype(jnp.float32)
    mu = jnp.mean(xf, axis=-1, keepdims=True)
    xc = xf - mu
    y = xc * lax.rsqrt(jnp.mean(xc * xc, axis=-1, keepdims=True) + EPS)
    return (y * g.astype(jnp.float32) + b.astype(jnp.float32)).astype(x.dtype)


def heads(t):
    return t.reshape(t.shape[:-1] + (NA_HEADS, HEAD_DIM))


def chunk_spatial_gating(u, v, ln_g, ln_b, ws, bs):
    B, N, _ = u.shape
    u = jax.nn.gelu(u)
    v = layer_norm(jax.nn.gelu(v), ln_g, ln_b)
    vg = v.reshape(B, N // CHUNK, CHUNK, GMLP_GROUPS, GMLP_GW)
    sv = jnp.einsum('gpq,bnqgc->bnpgc', ws, vg) + bs.T[:, :, None]
    return u * sv.reshape(B, N, W_A)


def fourier_mix(xf):
    B, N, _ = xf.shape
    xg = xf.reshape(B, N, F_GROUPS, F_GW).astype(jnp.float32)
    y = jnp.fft.fft2(xg, axes=(1, 3), norm="ortho").real
    return y.reshape(B, N, W_B).astype(xf.dtype)


def context_self_attention(qc, kc, vc):
    s = jnp.einsum('bqhd,bkhd->bhqk', qc, kc, preferred_element_type=jnp.float32) * (HEAD_DIM ** -0.5)
    p = jax.nn.softmax(s, axis=-1).astype(vc.dtype)
    o = jnp.einsum('bhqk,bkhd->bqhd', p, vc)
    return o.reshape(o.shape[:2] + (W_C,))


def neighbourhood_attention(q, k, v, kc, vc, rpb):
    B, S, H, Dh = q.shape
    rows = S // GRID_W
    kh = min(NA_KH, rows)
    r = jnp.arange(rows)
    row_start = jnp.clip(r - kh // 2, 0, rows - kh)
    row_idx = row_start[:, None] + jnp.arange(kh)[None, :]
    dr = row_idx - r[:, None]
    qg = q.reshape(B, rows, GRID_W, H, Dh)
    kg = k.reshape(B, rows, GRID_W, H, Dh)
    vg = v.reshape(B, rows, GRID_W, H, Dh)
    scale = HEAD_DIM ** -0.5
    outs = []
    for j in range(GRID_W // NA_KW):
        q0 = j * NA_KW
        band0 = min(max(q0 - NA_KW // 2, 0), GRID_W - NA_BAND)
        cols_q = q0 + np.arange(NA_KW)
        col_start = np.clip(cols_q - NA_KW // 2, 0, GRID_W - NA_KW)
        cols_k = band0 + np.arange(NA_BAND)
        col_mask = jnp.asarray((cols_k[None, :] >= col_start[:, None])
                               & (cols_k[None, :] < col_start[:, None] + NA_KW))
        dc = jnp.asarray(cols_k[None, :] - cols_q[:, None])
        qb = qg[:, :, q0:q0 + NA_KW]
        kb = kg[:, :, band0:band0 + NA_BAND][:, row_idx]
        vb = vg[:, :, band0:band0 + NA_BAND][:, row_idx]
        s_loc = jnp.einsum('brqhd,brkmhd->bhrqkm', qb, kb,
                           preferred_element_type=jnp.float32) * scale
        bias = rpb[:, dr[:, None, :, None] + (NA_KH - 1),
                   dc[None, :, None, :] + (NA_KW - 1)]
        s_loc = jnp.where(col_mask[None, None, None, :, None, :],
                          s_loc + bias.astype(jnp.float32)[None], -jnp.inf)
        s_loc = s_loc.reshape(B, H, rows, NA_KW, kh * NA_BAND)
        s_ctx = jnp.einsum('brqhd,bkhd->bhrqk', qb, kc,
                           preferred_element_type=jnp.float32) * scale
        p = jax.nn.softmax(jnp.concatenate([s_loc, s_ctx], axis=-1), axis=-1).astype(v.dtype)
        p_loc = p[..., :kh * NA_BAND].reshape(B, H, rows, NA_KW, kh, NA_BAND)
        p_ctx = p[..., kh * NA_BAND:]
        o = (jnp.einsum('bhrqkm,brkmhd->brqhd', p_loc, vb)
             + jnp.einsum('bhrqk,bkhd->brqhd', p_ctx, vc))
        outs.append(o)
    o = jnp.concatenate(outs, axis=2)
    return o.reshape(B, S, W_C)


def merge_branches(z, attn, ln_g, ln_b, ws, bs, w_pa, w_pf, w_pn, w_out):
    a = chunk_spatial_gating(z[..., OFF_U:OFF_VG], z[..., OFF_VG:OFF_GA], ln_g, ln_b, ws, bs) \
        * jax.nn.silu(z[..., OFF_GA:OFF_F])
    f = fourier_mix(z[..., OFF_F:OFF_GF]) * jax.nn.silu(z[..., OFF_GF:OFF_Q])
    n = attn * jax.nn.silu(z[..., OFF_GN:OFF_MERGE])
    g = jax.nn.sigmoid(z[..., OFF_MERGE:])
    g_a, g_f, g_n = g[..., :D_MODEL], g[..., D_MODEL:2 * D_MODEL], g[..., 2 * D_MODEL:]
    y = g_a * (a @ w_pa) + g_f * (f @ w_pf) + g_n * (n @ w_pn)
    return y @ w_out


def setup_inputs(seed: int = 0) -> dict:
    key = jax.random.key(seed)
    ks = jax.random.split(key, 20)
    L, D = DEPTH, D_MODEL

    def nrm(k, shape, s):
        return jax.random.normal(k, shape, jnp.float32) * s

    return {
        "x": nrm(ks[0], (BATCH, SEQ, D), 1.0),
        "c": nrm(ks[1], (BATCH, D), 1.0),
        "ctx": nrm(ks[2], (BATCH, CTX_LEN, D), 1.0),
        "c_ctx": nrm(ks[3], (D,), 1.0),
        "norm_g": 1.0 + nrm(ks[4], (L, D), 0.02),
        "w_ada": nrm(ks[5], (L, D, 3 * D), 0.5 * D ** -0.5),
        "b_ada": nrm(ks[6], (L, 3 * D), 0.01),
        "w_in": nrm(ks[7], (L, D, W_IN), D ** -0.5),
        "gmlp_ln_g": 1.0 + nrm(ks[8], (L, W_A), 0.02),
        "gmlp_ln_b": nrm(ks[9], (L, W_A), 0.02),
        "gmlp_ws": nrm(ks[10], (L, GMLP_GROUPS, CHUNK, CHUNK), CHUNK ** -0.5),
        "gmlp_bs": 1.0 + nrm(ks[11], (L, GMLP_GROUPS, CHUNK), 0.02),
        "q_norm_g": 1.0 + nrm(ks[12], (L, HEAD_DIM), 0.02),
        "k_norm_g": 1.0 + nrm(ks[13], (L, HEAD_DIM), 0.02),
        "rpb": nrm(ks[14], (L, NA_HEADS, 2 * NA_KH - 1, 2 * NA_KW - 1), 0.1),
        "w_pa": nrm(ks[15], (L, W_A, D), W_A ** -0.5),
        "w_pf": nrm(ks[16], (L, W_B, D), W_B ** -0.5),
        "w_pn": nrm(ks[17], (L, W_C, D), W_C ** -0.5),
        "w_out": nrm(ks[18], (L, D, D), D ** -0.5),
    }


def reference(x, c, ctx, c_ctx, norm_g, w_ada, b_ada, w_in, gmlp_ln_g, gmlp_ln_b, gmlp_ws,
              gmlp_bs, q_norm_g, k_norm_g, rpb, w_pa, w_pf, w_pn, w_out):
    D = D_MODEL
    silu_c = jax.nn.silu(c)
    silu_cc = jax.nn.silu(c_ctx)
    for l in range(DEPTH):
        last = l == DEPTH - 1
        mod = silu_c @ w_ada[l] + b_ada[l]
        shift, scale, gate = mod[:, :D], mod[:, D:2 * D], mod[:, 2 * D:]
        mod_c = silu_cc @ w_ada[l] + b_ada[l]
        shift_c, scale_c, gate_c = mod_c[:D], mod_c[D:2 * D], mod_c[2 * D:]

        h = rms_norm(x, norm_g[l]) * (1.0 + scale[:, None, :]) + shift[:, None, :]
        hc = rms_norm(ctx, norm_g[l]) * (1.0 + scale_c) + shift_c

        if last:
            zkv = hc @ w_in[l][:, OFF_K:OFF_GN]
            kc = rms_norm(heads(zkv[..., :W_C]), k_norm_g[l])
            vc = heads(zkv[..., W_C:])
        else:
            zc = hc @ w_in[l]
            qc = rms_norm(heads(zc[..., OFF_Q:OFF_K]), q_norm_g[l])
            kc = rms_norm(heads(zc[..., OFF_K:OFF_V]), k_norm_g[l])
            vc = heads(zc[..., OFF_V:OFF_GN])
            attn_c = context_self_attention(qc, kc, vc)
            out_c = merge_branches(zc, attn_c, gmlp_ln_g[l], gmlp_ln_b[l], gmlp_ws[l], gmlp_bs[l],
                                   w_pa[l], w_pf[l], w_pn[l], w_out[l])

        z = h @ w_in[l]
        q = rms_norm(heads(z[..., OFF_Q:OFF_K]), q_norm_g[l])
        k = rms_norm(heads(z[..., OFF_K:OFF_V]), k_norm_g[l])
        v = heads(z[..., OFF_V:OFF_GN])
        attn = neighbourhood_attention(q, k, v, kc, vc, rpb[l])
        out = merge_branches(z, attn, gmlp_ln_g[l], gmlp_ln_b[l], gmlp_ws[l], gmlp_bs[l],
                             w_pa[l], w_pf[l], w_pn[l], w_out[l])
        x = x + gate[:, None, :] * out
        if not last:
            ctx = ctx + gate_c * out_c
    return x
```

```cpp
#include <hip/hip_runtime.h>
#include <hip/hip_cooperative_groups.h>
#include <cstdio>
namespace cg = cooperative_groups;

#define LAS __attribute__((address_space(3)))
typedef unsigned short bf16_t;
typedef short bf16x8 __attribute__((ext_vector_type(8)));
typedef float f32x4 __attribute__((ext_vector_type(4)));
typedef float f32x2 __attribute__((ext_vector_type(2)));
typedef unsigned u32x4 __attribute__((ext_vector_type(4)));
typedef unsigned u32x2 __attribute__((ext_vector_type(2)));

constexpr int D = 2048, NB = 8, SEQ = 2048, CTX = 256, WIN = 15360;
constexpr int ML = NB * SEQ, MC = NB * CTX, MT = ML + MC;
constexpr int ZLD = 13312, OFF_U = 0, OFF_GA = 1024, OFF_F = 2048, OFF_GF = 3072, OFF_Q = 4096, OFF_K = 5120, OFF_GN = 6144, OFF_MERGE = 7168;
constexpr float EPS = 1e-6f;

constexpr size_t SZ_WINT = (size_t)WIN * D * 2, SZ_WPT = (size_t)D * 1024 * 2, SZ_WOT = (size_t)D * D * 2, SZ_WSB = (size_t)8 * 128 * 128 * 2;
constexpr size_t O_WINT = 0;
constexpr size_t O_WPT = O_WINT + SZ_WINT;
constexpr size_t O_WOT = O_WPT + 6 * SZ_WPT;
constexpr size_t O_WSB = O_WOT + 2 * SZ_WOT;
constexpr size_t O_MOD = O_WSB + 2 * SZ_WSB;
constexpr size_t O_DFTC = O_MOD + (size_t)2 * 9 * 6144 * 4;
constexpr size_t O_CSN = O_DFTC + (size_t)512 * 256 * 2;
constexpr size_t O_CSC = O_CSN + (size_t)2048 * 4096 * 2;
constexpr size_t O_H = O_CSC + (size_t)256 * 512 * 2;
constexpr size_t O_TT = O_H;
constexpr size_t O_TTC = O_TT + (size_t)32 * 256 * 4096 * 2;
constexpr size_t O_Y = O_H;
constexpr size_t O_Z = O_H + (size_t)MT * D * 2;
constexpr size_t O_VGT = O_Z + (size_t)MT * ZLD * 2;
constexpr size_t O_VT = O_VGT + (size_t)1024 * MT * 2;
constexpr size_t O_STATS = O_VT + (size_t)1024 * MT * 2;
constexpr size_t O_AB = O_STATS + (size_t)MT * 2 * 4;
constexpr size_t O_FB = O_AB + (size_t)MT * 1024 * 2;
constexpr size_t O_NB = O_FB + (size_t)MT * 1024 * 2;
constexpr size_t O_C1 = O_NB + (size_t)MT * 1024 * 2;
constexpr size_t WS_TOTAL = O_C1 + (size_t)MC * D * 4;
static_assert(WS_TOTAL <= (size_t)1006632960, "workspace budget");
static_assert((size_t)32 * 256 * 4096 * 2 + (size_t)32 * 256 * 512 * 2 <= (size_t)MT * D * 2, "TT alias");

struct Params {
    const float *x, *c, *ctx, *c_ctx, *norm_g, *w_ada, *b_ada, *w_in, *ln_g, *ln_b, *gws, *gbs, *qg, *kg, *rpb, *w_pa, *w_pf, *w_pn, *w_out;
    float* out;
    char* ws;
};

__device__ __forceinline__ unsigned cvt_pk_bf16(float lo, float hi) { unsigned r; asm volatile("v_cvt_pk_bf16_f32 %0, %1, %2" : "=v"(r) : "v"(lo), "v"(hi)); return r; }
__device__ __forceinline__ float bf_lo(unsigned u) { return __uint_as_float(u << 16); }
__device__ __forceinline__ float bf_hi(unsigned u) { return __uint_as_float(u & 0xffff0000u); }
__device__ __forceinline__ float bf2f(bf16_t b) { return __uint_as_float(((unsigned)b) << 16); }
__device__ __forceinline__ float sigmoid_f(float v) { return __builtin_amdgcn_rcpf(1.0f + __expf(-v)); }
__device__ __forceinline__ float silu_f(float v) { return v * sigmoid_f(v); }
__device__ __forceinline__ float gelu_f(float v) { const float u = 1.5957691216f * (v + 0.044715f * v * v * v); return v * sigmoid_f(u); }
template <int ACT> __device__ __forceinline__ float act_f(float v) {
    if (ACT == 1) return gelu_f(v);
    if (ACT == 2) return silu_f(v);
    if (ACT == 3) return sigmoid_f(v);
    return v;
}

constexpr int BM = 256, BK = 64, HALF = 128, HTB = HALF * BK * 2, STAGE_BYTES = 8 * HTB, NXCD = 8, WGM = 8;
__device__ __forceinline__ int lds_byte(int r, int c) { const int st = (r >> 4) * 2 + (c >> 5), rr = r & 15, cc = c & 31, ob = rr * 64 + cc * 2; return st * 1024 + (ob ^ (((ob >> 9) & 1) << 5)); }
__device__ __forceinline__ void stage_rc(int b, int& R, int& C) { const int st = b / 1024, sb = b % 1024, swz = sb ^ (((sb >> 9) & 1) << 5); R = (st >> 1) * 16 + swz / 64; C = (st & 1) * 32 + (swz % 64) / 2; }
__device__ __forceinline__ int perm32(int rho) { const int n = rho >> 4, i = rho & 15; return 8 * (i >> 2) + 4 * n + (i & 3); }

struct Unit { const char* a; const char* b; int pm, pn, kind; };

template <class Epi, class Sched>
__device__ __forceinline__ void gemm_phase(LAS unsigned char* lds, const int lda, const int ldb, const int K, const Sched& S, const Epi& E) {
    int tid_ = threadIdx.x; asm volatile("" : "+v"(tid_));
    const int tid = tid_, wid = __builtin_amdgcn_readfirstlane(tid >> 6), lane = tid & 63, wr = wid >> 2, wc = wid & 3, fr = lane & 15, fq = lane >> 4;
    const int nt = K / BK;
    unsigned voffA[2], voffB[2];
#pragma unroll
    for (int i = 0; i < 2; ++i) { int R, C; stage_rc(tid * 16 + i * 8192, R, C); const int Rb = (R & ~31) + perm32(R & 31);
        voffA[i] = (unsigned)(R * lda + C) * 2u; voffB[i] = (unsigned)(Rb * ldb + C) * 2u; }
    const size_t kstep = (size_t)(BK * 2);
    const size_t hstepA = (size_t)HALF * lda * 2, hstepB = (size_t)HALF * ldb * 2;
    const unsigned ldsw = (unsigned)wid * 1024u;
    const int aoff = lds_byte(wr * 64 + fr, fq * 8), boff = lds_byte(wc * 32 + fr, fq * 8);
#define PG8_SA(b, h) (((b) * 2 + (h)) * HTB)
#define PG8_SB(b, h) ((4 + (b) * 2 + (h)) * HTB)
#define PG8_STAGE(bufoff, gbase, voff) do { _Pragma("unroll") for (int _i = 0; _i < 2; ++_i) \
        __builtin_amdgcn_global_load_lds((const unsigned*)((const char*)(gbase) + (voff)[_i]), (LAS unsigned*)(lds + (bufoff) + ldsw + _i * 8192), 16, 0, 0); } while (0)
#define PG8_LDA(dst, b, h) do { _Pragma("unroll") for (int m = 0; m < 4; ++m) _Pragma("unroll") for (int k = 0; k < 2; ++k) dst[m][k] = *(const LAS bf16x8*)(lds + PG8_SA(b, h) + aoff + m * 2048 + k * 1024); } while (0)
#define PG8_LDB(dst, b, h) do { _Pragma("unroll") for (int n = 0; n < 2; ++n) _Pragma("unroll") for (int k = 0; k < 2; ++k) dst[n][k] = *(const LAS bf16x8*)(lds + PG8_SB(b, h) + boff + n * 2048 + k * 1024); } while (0)
#define PG8_MMA(ai, bj, At, Bt) do { __builtin_amdgcn_s_setprio(1); _Pragma("unroll") for (int m = 0; m < 4; ++m) _Pragma("unroll") for (int n = 0; n < 2; ++n) _Pragma("unroll") for (int k = 0; k < 2; ++k) \
        acc[ai][bj][m][n] = __builtin_amdgcn_mfma_f32_16x16x32_bf16(Bt[n][k], At[m][k], acc[ai][bj][m][n], 0, 0, 0); __builtin_amdgcn_s_setprio(0); } while (0)
#define PG8_WAIT_V(n) asm volatile("s_waitcnt vmcnt(" #n ")" ::: "memory")
#define PG8_WAIT_L(n) asm volatile("s_waitcnt lgkmcnt(" #n ")" ::: "memory")
#define PG8_BAR __builtin_amdgcn_s_barrier()
#define PG8_SCHED __builtin_amdgcn_sched_barrier(0)
    Unit cur, nxt; int ui = 0;
    if (!S.next(0, cur)) return;
    f32x4 acc[2][2][4][2];
#pragma unroll
    for (int a = 0; a < 2; ++a)
#pragma unroll
        for (int b = 0; b < 2; ++b)
#pragma unroll
            for (int m = 0; m < 4; ++m)
#pragma unroll
                for (int n = 0; n < 2; ++n) acc[a][b][m][n] = (f32x4){0.f, 0.f, 0.f, 0.f};
    bf16x8 At[4][2], B0[2][2], B1[2][2];
    const char* cA = cur.a; const char* cB = cur.b;
    PG8_STAGE(PG8_SB(0, 0), cB, voffB); PG8_STAGE(PG8_SA(0, 0), cA, voffA); PG8_STAGE(PG8_SB(0, 1), cB + hstepB, voffB); PG8_STAGE(PG8_SA(0, 1), cA + hstepA, voffA);
    if (wr == 1) PG8_BAR;
    PG8_WAIT_V(4); PG8_BAR;
    PG8_STAGE(PG8_SB(1, 0), cB + kstep, voffB); PG8_STAGE(PG8_SA(1, 0), cA + kstep, voffA); PG8_STAGE(PG8_SB(1, 1), cB + hstepB + kstep, voffB);
    PG8_WAIT_V(6); PG8_BAR;
#pragma unroll 1
    for (;;) {
        const bool has_next = S.next(ui + 1, nxt);
        const char* nA = has_next ? nxt.a : cA; const char* nB = has_next ? nxt.b : cB;
#pragma unroll 1
        for (int t = 0; t < nt; t += 2) {
            const bool last = (t == nt - 2);
            const char* a1 = cA + (size_t)(t + 1) * kstep;
            const char* a2 = last ? nA : cA + (size_t)(t + 2) * kstep; const char* b2 = last ? nB : cB + (size_t)(t + 2) * kstep;
            const char* a3 = a2 + kstep; const char* b3 = b2 + kstep;
            PG8_LDB(B0, 0, 0); PG8_SCHED; PG8_LDA(At, 0, 0); PG8_STAGE(PG8_SA(1, 1), a1 + hstepA, voffA);
            PG8_WAIT_L(8); PG8_BAR; PG8_WAIT_L(0); PG8_MMA(0, 0, At, B0); PG8_BAR; PG8_SCHED;
            PG8_LDB(B1, 0, 1); PG8_STAGE(PG8_SB(0, 0), b2, voffB);
            PG8_BAR; PG8_WAIT_L(0); PG8_MMA(0, 1, At, B1); PG8_BAR;
            PG8_LDA(At, 0, 1); PG8_STAGE(PG8_SA(0, 0), a2, voffA);
            PG8_BAR; PG8_WAIT_L(0); PG8_MMA(1, 0, At, B0); PG8_BAR; PG8_SCHED;
            PG8_STAGE(PG8_SB(0, 1), b2 + hstepB, voffB);
            PG8_WAIT_V(6); PG8_BAR; PG8_MMA(1, 1, At, B1); PG8_BAR;
            PG8_LDB(B0, 1, 0); PG8_SCHED; PG8_LDA(At, 1, 0); PG8_STAGE(PG8_SA(0, 1), a2 + hstepA, voffA);
            PG8_WAIT_L(8); PG8_BAR; PG8_WAIT_L(0); PG8_MMA(0, 0, At, B0); PG8_BAR; PG8_SCHED;
            PG8_LDB(B1, 1, 1); PG8_STAGE(PG8_SB(1, 0), b3, voffB);
            PG8_BAR; PG8_WAIT_L(0); PG8_MMA(0, 1, At, B1); PG8_BAR;
            PG8_LDA(At, 1, 1); PG8_STAGE(PG8_SA(1, 0), a3, voffA);
            PG8_BAR; PG8_WAIT_L(0); PG8_MMA(1, 0, At, B0); PG8_BAR; PG8_SCHED;
            PG8_STAGE(PG8_SB(1, 1), b3 + hstepB, voffB);
            PG8_WAIT_V(6); PG8_BAR; PG8_MMA(1, 1, At, B1); PG8_BAR;
        }
        const bool keep = E(acc, cur, wr, wc, fr, fq);
        if (!has_next) break;
        if (!keep) {
#pragma unroll
            for (int a = 0; a < 2; ++a)
#pragma unroll
                for (int b = 0; b < 2; ++b)
#pragma unroll
                    for (int m = 0; m < 4; ++m)
#pragma unroll
                        for (int n = 0; n < 2; ++n) acc[a][b][m][n] = (f32x4){0.f, 0.f, 0.f, 0.f};
        }
        cur = nxt; cA = nA; cB = nB; ++ui;
    }
    PG8_WAIT_V(0);
    if (wr == 0) PG8_BAR;
    PG8_BAR;
#undef PG8_SA
#undef PG8_SB
#undef PG8_STAGE
#undef PG8_LDA
#undef PG8_LDB
#undef PG8_MMA
#undef PG8_WAIT_V
#undef PG8_WAIT_L
#undef PG8_BAR
#undef PG8_SCHED
}

__device__ __forceinline__ void remap_tile(int L, int nM, int nN, int& pm, int& pn) {
    const int nwg = nM * nN;
    int wgid = L; { const int q = nwg / NXCD, r = nwg % NXCD, xcd = wgid % NXCD, off = wgid / NXCD; wgid = (xcd < r ? xcd * (q + 1) : r * (q + 1) + (xcd - r) * q) + off; }
    const int nig = WGM * nN, gid = wgid / nig, fm = gid * WGM, gsz = (nM - fm) < WGM ? (nM - fm) : WGM;
    pm = fm + ((wgid % nig) % gsz); pn = (wgid % nig) / gsz;
}
struct SchedMain {
    const char* h; const char* wt; int nM, extra, G, c;
    __device__ __forceinline__ bool next(int i, Unit& u) const {
        const int nN = 60, nwg = nM * nN;
        const int L = i * G + c; if (L >= nwg + extra) return false;
        int pm, pn;
        if (L < nwg) {
            int wgid = L; { const int q = nwg / NXCD, r = nwg % NXCD, xcd = wgid % NXCD, off = wgid / NXCD; wgid = (xcd < r ? xcd * (q + 1) : r * (q + 1) + (xcd - r) * q) + off; }
            const int nig = WGM * nN, gid = wgid / nig, fm = gid * WGM, gsz = (nM - fm) < WGM ? (nM - fm) : WGM;
            pm = fm + ((wgid % nig) % gsz); pn = (wgid % nig) / gsz;
        } else { const int e = L - nwg; pm = 64 + (e >> 3); pn = 24 + (e & 7); }
        const bool sw = (pn >= 4 && pn < 8) || (pn >= 28 && pn < 32);
        const char* ap = h + (size_t)pm * (BM * D * 2); const char* bp = wt + (size_t)pn * (BM * D * 2);
        u.a = sw ? bp : ap; u.b = sw ? ap : bp; u.pm = pm; u.pn = pn;
        int kind;
        if (pn < 4) kind = 1; else if (pn < 8) kind = 4; else if (pn < 12) kind = 2; else if (pn < 16) kind = 0; else if (pn < 20) kind = 2;
        else if (pn < 28) kind = 0; else if (pn < 32) kind = 5; else if (pn < 36) kind = 2; else kind = 0;
        u.kind = kind; return true;
    }
};
template <int ACT> __device__ __forceinline__ void store_tile_bf16(const f32x4 (&acc)[2][2][4][2], bf16_t* base  , const size_t ld) {
#pragma unroll
    for (int ai = 0; ai < 2; ++ai)
#pragma unroll
        for (int m = 0; m < 4; ++m) { bf16_t* rowp = base + (size_t)(ai * HALF + m * 16) * ld;
#pragma unroll
            for (int bj = 0; bj < 2; ++bj) { const f32x4 v0 = acc[ai][bj][m][0], v1 = acc[ai][bj][m][1];
                u32x4 w; w.x = cvt_pk_bf16(act_f<ACT>(v0[0]), act_f<ACT>(v0[1])); w.y = cvt_pk_bf16(act_f<ACT>(v0[2]), act_f<ACT>(v0[3]));
                w.z = cvt_pk_bf16(act_f<ACT>(v1[0]), act_f<ACT>(v1[1])); w.w = cvt_pk_bf16(act_f<ACT>(v1[2]), act_f<ACT>(v1[3]));
                *(u32x4*)(rowp + bj * HALF) = w; } }
}
struct EpiMain {
    bf16_t* z; bf16_t* vgT; bf16_t* vT;
    __device__ __forceinline__ bool operator()(const f32x4 (&acc)[2][2][4][2], const Unit& u, int wr, int wc, int fr, int fq) const {
        if (u.kind < 4) {
            bf16_t* base = z + (size_t)(u.pm * BM + wr * 64 + fr) * ZLD + ((u.pn < 4 ? u.pn : u.pn < 28 ? u.pn - 4 : u.pn - 8) * BM + wc * 32 + 8 * fq);
            if (u.kind == 0) store_tile_bf16<0>(acc, base, ZLD);
            else if (u.kind == 1) store_tile_bf16<1>(acc, base, ZLD);
            else if (u.kind == 2) store_tile_bf16<2>(acc, base, ZLD);
            else store_tile_bf16<3>(acc, base, ZLD);
        } else {
            if (u.kind == 4) { bf16_t* base = vgT + (size_t)((u.pn - 4) * BM + wr * 64 + fr) * MT + (u.pm * BM + wc * 32 + 8 * fq); store_tile_bf16<1>(acc, base, MT); }
            else { bf16_t* base = vT + (size_t)((u.pn - 28) * BM + wr * 64 + fr) * MT + (u.pm * BM + wc * 32 + 8 * fq); store_tile_bf16<0>(acc, base, MT); }
        }
        return false;
    }
};

struct SchedF1 {
    const char* dft; const char* z; int nunits, G, c;
    __device__ __forceinline__ bool next(int i, Unit& u) const {
        const int L = i * G + c; if (L >= nunits) return false;
        const int mt = L & 1, g = (L >> 1) & 3, tt = L >> 3;
        u.a = dft + (size_t)mt * (256 * 256 * 2); u.b = z + ((size_t)tt * BM * ZLD + OFF_F + g * 256) * 2; u.pm = mt; u.pn = tt; u.kind = g; return true;
    }
};
struct EpiF1 {
    bf16_t* TT; bf16_t* TTc;
    __device__ __forceinline__ bool operator()(const f32x4 (&acc)[2][2][4][2], const Unit& u, int wr, int wc, int fr, int fq) const {
        const int g = u.kind, cs = u.pm, tt = u.pn;
        const int k0 = wr * 64 + fr, n0 = wc * 32 + 8 * fq;
        bf16_t* base; size_t ld;
        if (tt < 64) { const int b = tt >> 3; base = TT + ((size_t)((b * 4 + g) * 256 + k0)) * 4096 + cs * 2048 + (tt & 7) * 256 + n0; ld = 4096; }
        else { const int b = tt - 64; base = TTc + ((size_t)((b * 4 + g) * 256 + k0)) * 512 + cs * 256 + n0; ld = 512; }
        store_tile_bf16<0>(acc, base, ld);
        return false;
    }
};

struct SchedF2 {
    const char* cs; const char* tt; int nunits, ctxmode, G, c;
    __device__ __forceinline__ bool next(int i, Unit& u) const {
        const int L = i * G + c; if (L >= nunits) return false;
        if (!ctxmode) { const int bg = (L & 7) + 8 * (L >> 6), pt = (L >> 3) & 7; u.a = cs + (size_t)pt * (256 * 4096 * 2); u.b = tt + (size_t)bg * (256 * 4096 * 2); u.pm = pt; u.pn = bg; }
        else { u.a = cs; u.b = tt + (size_t)L * (256 * 512 * 2); u.pm = 0; u.pn = L; }
        u.kind = 0; return true;
    }
};
struct EpiF2 {
    const bf16_t* z; bf16_t* fb; int ctxmode; float scale;
    __device__ __forceinline__ bool operator()(const f32x4 (&acc)[2][2][4][2], const Unit& u, int wr, int wc, int fr, int fq) const {
        const int b = u.pn >> 2, g = u.pn & 3;
        const int row0 = (ctxmode ? ML + b * CTX : b * SEQ + u.pm * BM) + wr * 64 + fr, ch0 = g * 256 + wc * 32 + 8 * fq;
#pragma unroll
        for (int ai = 0; ai < 2; ++ai)
#pragma unroll
            for (int m = 0; m < 4; ++m) { const size_t row = (size_t)(row0 + ai * HALF + m * 16);
#pragma unroll
                for (int bj = 0; bj < 2; ++bj) { const f32x4 v0 = acc[ai][bj][m][0] * scale, v1 = acc[ai][bj][m][1] * scale;
                    const u32x4 gq = *(const u32x4*)(z + row * ZLD + OFF_GF + ch0 + bj * HALF);
                    u32x4 w; w.x = cvt_pk_bf16(v0[0] * bf_lo(gq.x), v0[1] * bf_hi(gq.x)); w.y = cvt_pk_bf16(v0[2] * bf_lo(gq.y), v0[3] * bf_hi(gq.y));
                    w.z = cvt_pk_bf16(v1[0] * bf_lo(gq.z), v1[1] * bf_hi(gq.z)); w.w = cvt_pk_bf16(v1[2] * bf_lo(gq.w), v1[3] * bf_hi(gq.w));
                    *(u32x4*)(fb + row * 1024 + ch0 + bj * HALF) = w; }
                __builtin_amdgcn_sched_barrier(0); }
        return false;
    }
};

struct SchedMerge {
    const char* ab; const char* wp; int ntiles, G, c;
    __device__ __forceinline__ bool next(int i, Unit& u) const {
        const int t = i / 3, br = i - 3 * t; const int L = t * G + c; if (L >= ntiles) return false;
        int pm, pn; remap_tile(L, ntiles >> 3, 8, pm, pn);
        u.a = ab + (size_t)br * ((size_t)MT * 1024 * 2) + (size_t)pm * (BM * 1024 * 2); u.b = wp + (size_t)br * SZ_WPT + (size_t)pn * (BM * 1024 * 2);
        u.pm = pm; u.pn = pn; u.kind = br; return true;
    }
};
struct EpiMerge {
    const bf16_t* z; bf16_t* y;
    __device__ __forceinline__ bool operator()(f32x4 (&acc)[2][2][4][2], const Unit& u, int wr, int wc, int fr, int fq) const {
        const int br = u.kind;
        const int row0 = u.pm * BM + wr * 64 + fr, col0 = u.pn * BM + wc * 32 + 8 * fq;
#pragma unroll
        for (int ai = 0; ai < 2; ++ai)
#pragma unroll
            for (int m = 0; m < 4; ++m) { const size_t row = (size_t)(row0 + ai * HALF + m * 16);
#pragma unroll
                for (int bj = 0; bj < 2; ++bj) {
                    const bf16_t* gp = z + row * ZLD + OFF_MERGE + br * D + col0 + bj * HALF;
                    const u32x4 g0 = *(const u32x4*)gp;
                    float f[8] = {bf_lo(g0.x), bf_hi(g0.x), bf_lo(g0.y), bf_hi(g0.y), bf_lo(g0.z), bf_hi(g0.z), bf_lo(g0.w), bf_hi(g0.w)};
#pragma unroll
                    for (int j = 0; j < 8; ++j) f[j] = sigmoid_f(f[j]);
                    if (br < 2) { const u32x4 g1 = *(const u32x4*)(gp + D);
                        const float d[8] = {bf_lo(g1.x), bf_hi(g1.x), bf_lo(g1.y), bf_hi(g1.y), bf_lo(g1.z), bf_hi(g1.z), bf_lo(g1.w), bf_hi(g1.w)};
#pragma unroll
                        for (int j = 0; j < 8; ++j) f[j] = f[j] * (1.0f + __expf(-d[j]));
                    }
#pragma unroll
                    for (int j = 0; j < 4; ++j) { acc[ai][bj][m][0][j] *= f[j]; acc[ai][bj][m][1][j] *= f[4 + j]; }
                    if (br == 2) { const f32x4 v0 = acc[ai][bj][m][0], v1 = acc[ai][bj][m][1];
                        u32x4 w; w.x = cvt_pk_bf16(v0[0], v0[1]); w.y = cvt_pk_bf16(v0[2], v0[3]); w.z = cvt_pk_bf16(v1[0], v1[1]); w.w = cvt_pk_bf16(v1[2], v1[3]);
                        *(u32x4*)(y + row * D + col0 + bj * HALF) = w; }
                    __builtin_amdgcn_sched_barrier(0); } }
        return br < 2;
    }
};

struct SchedOut {
    const char* y; const char* wo; int ntiles, G, c;
    __device__ __forceinline__ bool next(int i, Unit& u) const {
        const int L = i * G + c; if (L >= ntiles) return false;
        int pm, pn; remap_tile(L, ntiles >> 3, 8, pm, pn);
        u.a = y + (size_t)pm * (BM * D * 2); u.b = wo + (size_t)pn * (BM * D * 2); u.pm = pm; u.pn = pn; u.kind = 0; return true;
    }
};
struct EpiOut {
    const float* xin; const float* cin; float* xout; float* cout; const float* mod;
    __device__ __forceinline__ bool operator()(const f32x4 (&acc)[2][2][4][2], const Unit& u, int wr, int wc, int fr, int fq) const {
        const int col0 = u.pn * BM + wc * 32 + 8 * fq;
        const bool isctx = u.pm >= 64;
        const int brow = isctx ? 8 : (u.pm >> 3);
        const float* gate = mod + brow * 6144 + 2 * D + col0;
        const size_t rbase = isctx ? (size_t)(u.pm - 64) * BM : (size_t)u.pm * BM;
        const float* src = (isctx ? cin : xin) + (rbase + wr * 64 + fr) * D + col0;
        float* dst = (isctx ? cout : xout) + (rbase + wr * 64 + fr) * D + col0;
#pragma unroll
        for (int bj = 0; bj < 2; ++bj) { const f32x4 ga = *(const f32x4*)(gate + bj * HALF), gb = *(const f32x4*)(gate + bj * HALF + 4);
#pragma unroll
            for (int ai = 0; ai < 2; ++ai)
#pragma unroll
                for (int m = 0; m < 4; ++m) { const size_t o = (size_t)(ai * HALF + m * 16) * D + bj * HALF;
                    const f32x4 x0 = *(const f32x4*)(src + o), x1 = *(const f32x4*)(src + o + 4);
                    *(f32x4*)(dst + o) = x0 + ga * acc[ai][bj][m][0]; *(f32x4*)(dst + o + 4) = x1 + gb * acc[ai][bj][m][1];
                    __builtin_amdgcn_sched_barrier(0); } }
        return false;
    }
};

__device__ __forceinline__ void transpose_tile(const float* __restrict__ src, bf16_t* __restrict__ dst, int R, int C, int tile, unsigned char* smem) {
    const int nct = C >> 8; const int rt = tile / nct, ct = tile - rt * nct; const int r0 = rt * 64, c0 = ct * 256;
    unsigned* tl = (unsigned*)smem;
    int tid_ = threadIdx.x; asm volatile("" : "+v"(tid_));
    const int tid = tid_;
    f32x4 v[8];
#pragma unroll
    for (int i = 0; i < 8; ++i) { const int idx = tid + i * 512, r = idx >> 6, c4 = (idx & 63) * 4; v[i] = *(const f32x4*)(src + (size_t)(r0 + r) * C + c0 + c4); }
#pragma unroll
    for (int i = 0; i < 8; ++i) { const int idx = tid + i * 512, r = idx >> 6, c4 = (idx & 63) * 4; tl[r * 129 + (c4 >> 1)] = cvt_pk_bf16(v[i][0], v[i][1]); tl[r * 129 + (c4 >> 1) + 1] = cvt_pk_bf16(v[i][2], v[i][3]); }
    __syncthreads();
    const bf16_t* ts = (const bf16_t*)smem;
#pragma unroll
    for (int i = 0; i < 4; ++i) { const int idx = tid + i * 512, c = idx >> 3, r8 = (idx & 7) * 8;
        unsigned short e[8];
#pragma unroll
        for (int j = 0; j < 8; ++j) e[j] = ts[(r8 + j) * 258 + c];
        u32x4 w; w.x = e[0] | ((unsigned)e[1] << 16); w.y = e[2] | ((unsigned)e[3] << 16); w.z = e[4] | ((unsigned)e[5] << 16); w.w = e[6] | ((unsigned)e[7] << 16);
        *(u32x4*)(dst + (size_t)(c0 + c) * R + r0 + r8) = w; }
    __syncthreads();
}

__device__ void phase0(const Params& p, unsigned char* smem) {
    int tid_ = threadIdx.x; asm volatile("" : "+v"(tid_));
    const int tid = tid_, bid = blockIdx.x, G = gridDim.x;
    char* ws = p.ws;
    {
        float* sc = (float*)smem;
        float* red = (float*)(smem + 9 * 2048 * 4);
        bool filled = false;
        for (int task = bid; task < 192; task += G) {
            if (!filled) { for (int i = tid; i < 9 * 2048; i += 512) { const int r = i >> 11, k = i & 2047; const float v = r < 8 ? p.c[r * D + k] : p.c_ctx[k]; sc[i] = silu_f(v); } filled = true; __syncthreads(); }
            const int l = task / 96, jb = task % 96; const int col = tid & 63, part = tid >> 6;
            const float* w = p.w_ada + (size_t)l * D * 6144 + jb * 64 + col;
            float a[9];
#pragma unroll
            for (int r = 0; r < 9; ++r) a[r] = 0.f;
            for (int kk = 0; kk < 256; ++kk) { const int k = part * 256 + kk; const float wv = w[(size_t)k * 6144];
#pragma unroll
                for (int r = 0; r < 9; ++r) a[r] += sc[r * 2048 + k] * wv; }
#pragma unroll
            for (int r = 0; r < 9; ++r) red[(part * 9 + r) * 64 + col] = a[r];
            __syncthreads();
            for (int i = tid; i < 9 * 64; i += 512) { const int r = i >> 6, cc = i & 63; float s = 0.f;
#pragma unroll
                for (int q = 0; q < 8; ++q) s += red[(q * 9 + r) * 64 + cc];
                ((float*)(ws + O_MOD))[(l * 9 + r) * 6144 + jb * 64 + cc] = s + p.b_ada[l * 6144 + jb * 64 + cc]; }
            __syncthreads();
        }
        __syncthreads();
    }
    {
        constexpr int T_IN = (D / 64) * (WIN / 256), T_P = (1024 / 64) * (D / 256), T_O = (D / 64) * (D / 256);
        constexpr int T_TOT = T_IN + 6 * T_P + 2 * T_O;
        for (int task = bid; task < T_TOT; task += G) {
            int t = task;
            if (t < T_IN) { transpose_tile(p.w_in, (bf16_t*)(ws + O_WINT), D, WIN, t, smem); continue; }
            t -= T_IN;
            if (t < 6 * T_P) { const int w = t / T_P; t -= w * T_P; const int l = w / 3, br = w % 3; const float* s = (br == 0 ? p.w_pa : br == 1 ? p.w_pf : p.w_pn) + (size_t)l * 1024 * D;
                transpose_tile(s, (bf16_t*)(ws + O_WPT + (size_t)(l * 3 + br) * SZ_WPT), 1024, D, t, smem); continue; }
            t -= 6 * T_P;
            { const int l = t / T_O; t -= l * T_O; transpose_tile(p.w_out + (size_t)l * D * D, (bf16_t*)(ws + O_WOT + l * SZ_WOT), D, D, t, smem); }
        }
    }
    {
        const size_t gt = (size_t)bid * 512 + tid, gs = (size_t)G * 512;
        bf16_t* wsb = (bf16_t*)(ws + O_WSB);
        for (size_t i = gt; i < (size_t)2 * 8 * 128 * 128 / 2; i += gs) ((unsigned*)wsb)[i] = cvt_pk_bf16(p.gws[2 * i], p.gws[2 * i + 1]);
        unsigned* dftc = (unsigned*)(ws + O_DFTC);
        for (size_t i = gt; i < (size_t)512 * 256 / 2; i += gs) { const int kp = (int)(i >> 7), c = (int)(i & 127) * 2, k = kp & 255; float v[2];
#pragma unroll
            for (int j = 0; j < 2; ++j) { const int ang = (k * (c + j)) & 255; float s, co; sincospif((float)ang * (1.0f / 128.0f), &s, &co); v[j] = kp < 256 ? co : s; }
            dftc[i] = cvt_pk_bf16(v[0], v[1]); }
        unsigned* csn = (unsigned*)(ws + O_CSN);
        for (size_t i = gt; i < (size_t)2048 * 4096 / 2; i += gs) { const int pp = (int)(i >> 11), n2 = (int)(i & 2047) * 2; float v[2];
#pragma unroll
            for (int j = 0; j < 2; ++j) { const int nn = n2 + j, n = nn & 2047; const int ang = (pp * n) & 2047; float s, co; sincospif((float)ang * (1.0f / 1024.0f), &s, &co); v[j] = nn < 2048 ? co : -s; }
            csn[i] = cvt_pk_bf16(v[0], v[1]); }
        unsigned* csc = (unsigned*)(ws + O_CSC);
        for (size_t i = gt; i < (size_t)256 * 512 / 2; i += gs) { const int pp = (int)(i >> 8), n2 = (int)(i & 255) * 2; float v[2];
#pragma unroll
            for (int j = 0; j < 2; ++j) { const int nn = n2 + j, n = nn & 255; const int ang = (pp * n) & 255; float s, co; sincospif((float)ang * (1.0f / 128.0f), &s, &co); v[j] = nn < 256 ? co : -s; }
            csc[i] = cvt_pk_bf16(v[0], v[1]); }
    }
}

__device__ void phase_norm(const Params& p, int l, const float* xin, const float* cin) {
    int tid_ = threadIdx.x; asm volatile("" : "+v"(tid_));
    const int lane = tid_ & 63, gw = blockIdx.x * 8 + (tid_ >> 6), nw = gridDim.x * 8;
    const float* mod = (const float*)(p.ws + O_MOD) + (size_t)l * 9 * 6144;
    const float* ng = p.norm_g + l * D;
    bf16_t* h = (bf16_t*)(p.ws + O_H);
    for (int row = gw; row < MT; row += nw) {
        const float* src = row < ML ? xin + (size_t)row * D : cin + (size_t)(row - ML) * D;
        const int br = row < ML ? (row >> 11) : 8;
        const float* mr = mod + br * 6144;
        f32x4 v[8]; float ss = 0.f;
#pragma unroll
        for (int i = 0; i < 8; ++i) { v[i] = *(const f32x4*)(src + i * 256 + lane * 4); ss += v[i][0] * v[i][0] + v[i][1] * v[i][1] + v[i][2] * v[i][2] + v[i][3] * v[i][3]; }
#pragma unroll
        for (int o = 32; o >= 1; o >>= 1) ss += __shfl_xor(ss, o);
        const float rstd = rsqrtf(ss * (1.0f / D) + EPS);
#pragma unroll
        for (int i = 0; i < 8; ++i) { const int d = i * 256 + lane * 4;
            const f32x4 g = *(const f32x4*)(ng + d), sh = *(const f32x4*)(mr + d), scl = *(const f32x4*)(mr + D + d);
            const f32x4 o = (v[i] * rstd * g) * (scl + 1.0f) + sh;
            u32x2 w; w.x = cvt_pk_bf16(o[0], o[1]); w.y = cvt_pk_bf16(o[2], o[3]);
            *(u32x2*)(h + (size_t)row * D + d) = w; }
    }
}

__device__ void phase_qknorm(const Params& p, int l, int last) {
    int tid_ = threadIdx.x; asm volatile("" : "+v"(tid_));
    const int lane = tid_ & 63, gw = blockIdx.x * 8 + (tid_ >> 6), nw = gridDim.x * 8;
    bf16_t* z = (bf16_t*)(p.ws + O_Z);
    const int ntask = 2 * MT;
    for (int task = gw; task < ntask; task += nw) {
        const int row = task >> 1, isk = task & 1;
        if (last && row >= ML && !isk) continue;
        bf16_t* ptr = z + (size_t)row * ZLD + (isk ? OFF_K : OFF_Q) + lane * 16;
        const float* g = (isk ? p.kg : p.qg) + l * 128 + (lane & 7) * 16;
        const u32x4 a = *(const u32x4*)ptr, b = *(const u32x4*)(ptr + 8);
        float f[16] = {bf_lo(a.x), bf_hi(a.x), bf_lo(a.y), bf_hi(a.y), bf_lo(a.z), bf_hi(a.z), bf_lo(a.w), bf_hi(a.w),
                       bf_lo(b.x), bf_hi(b.x), bf_lo(b.y), bf_hi(b.y), bf_lo(b.z), bf_hi(b.z), bf_lo(b.w), bf_hi(b.w)};
        float ss = 0.f;
#pragma unroll
        for (int j = 0; j < 16; ++j) ss += f[j] * f[j];
        ss += __shfl_xor(ss, 1); ss += __shfl_xor(ss, 2); ss += __shfl_xor(ss, 4);
        float rs = rsqrtf(ss * (1.0f / 128.0f) + EPS);
        if (!isk) rs *= 0.08838834764831845f;
#pragma unroll
        for (int j = 0; j < 16; ++j) f[j] = f[j] * rs * g[j];
        u32x4 oa, ob;
        oa.x = cvt_pk_bf16(f[0], f[1]); oa.y = cvt_pk_bf16(f[2], f[3]); oa.z = cvt_pk_bf16(f[4], f[5]); oa.w = cvt_pk_bf16(f[6], f[7]);
        ob.x = cvt_pk_bf16(f[8], f[9]); ob.y = cvt_pk_bf16(f[10], f[11]); ob.z = cvt_pk_bf16(f[12], f[13]); ob.w = cvt_pk_bf16(f[14], f[15]);
        *(u32x4*)ptr = oa; *(u32x4*)(ptr + 8) = ob;
    }
}
__device__ void phase_lnstats(const Params& p, int ntok, unsigned char* smem) {
    int tid_ = threadIdx.x; asm volatile("" : "+v"(tid_));
    const int tid = tid_, tk = tid & 63, part = tid >> 6;
    const bf16_t* vgT = (const bf16_t*)(p.ws + O_VGT);
    float* stats = (float*)(p.ws + O_STATS);
    float* red = (float*)smem;
    for (int task = blockIdx.x; task < ntok / 64; task += gridDim.x) {
        const int tok = task * 64 + tk; float s = 0.f, q = 0.f;
        const bf16_t* src = vgT + (size_t)(part * 128) * MT + tok;
#pragma unroll 8
        for (int i = 0; i < 128; ++i) { const float v = bf2f(src[(size_t)i * MT]); s += v; q += v * v; }
        red[(part * 64 + tk) * 2] = s; red[(part * 64 + tk) * 2 + 1] = q;
        __syncthreads();
        if (part == 0) { float S = 0.f, Q = 0.f;
#pragma unroll
            for (int j = 0; j < 8; ++j) { S += red[(j * 64 + tk) * 2]; Q += red[(j * 64 + tk) * 2 + 1]; }
            const float mu = S * (1.0f / 1024.0f); const float var = fmaxf(Q * (1.0f / 1024.0f) - mu * mu, 0.f);
            stats[2 * tok] = mu; stats[2 * tok + 1] = rsqrtf(var + EPS); }
        __syncthreads();
    }
}

__device__ __forceinline__ void gmlp_task(const Params& p, int l, int task, int lane) {
    const int fr = lane & 15, fq = lane >> 4;
    const int cblk = task & 7, g = (task >> 3) & 7, ck = task >> 6;
    const int row0 = ck * 128;
    const bf16_t* vgT = (const bf16_t*)(p.ws + O_VGT);
    const float* stats = (const float*)(p.ws + O_STATS);
    const bf16_t* wsb = (const bf16_t*)(p.ws + O_WSB) + (size_t)(l * 8 + g) * 128 * 128;
    const bf16_t* z = (const bf16_t*)(p.ws + O_Z);
    bf16_t* ab = (bf16_t*)(p.ws + O_AB);
    const int ch = g * 128 + cblk * 16 + fr;
    const float lg = p.ln_g[l * 1024 + ch], lb = p.ln_b[l * 1024 + ch];
    bf16x8 af[4];
#pragma unroll
    for (int ks = 0; ks < 4; ++ks) { const int q0 = ks * 32 + fq * 8;
        const u32x4 raw = *(const u32x4*)(vgT + (size_t)ch * MT + row0 + q0);
        const float* st = stats + (size_t)(row0 + q0) * 2;
        const f32x4 s0 = *(const f32x4*)st, s1 = *(const f32x4*)(st + 4), s2 = *(const f32x4*)(st + 8), s3 = *(const f32x4*)(st + 12);
        const float e0 = (bf_lo(raw.x) - s0[0]) * s0[1] * lg + lb, e1 = (bf_hi(raw.x) - s0[2]) * s0[3] * lg + lb;
        const float e2 = (bf_lo(raw.y) - s1[0]) * s1[1] * lg + lb, e3 = (bf_hi(raw.y) - s1[2]) * s1[3] * lg + lb;
        const float e4 = (bf_lo(raw.z) - s2[0]) * s2[1] * lg + lb, e5 = (bf_hi(raw.z) - s2[2]) * s2[3] * lg + lb;
        const float e6 = (bf_lo(raw.w) - s3[0]) * s3[1] * lg + lb, e7 = (bf_hi(raw.w) - s3[2]) * s3[3] * lg + lb;
        u32x4 w; w.x = cvt_pk_bf16(e0, e1); w.y = cvt_pk_bf16(e2, e3); w.z = cvt_pk_bf16(e4, e5); w.w = cvt_pk_bf16(e6, e7);
        af[ks] = __builtin_bit_cast(bf16x8, w); }
    const float* bs = p.gbs + (l * 8 + g) * 128;
#pragma unroll 2
    for (int pb = 0; pb < 8; ++pb) {
        f32x4 acc = {0.f, 0.f, 0.f, 0.f};
#pragma unroll
        for (int ks = 0; ks < 4; ++ks) { const bf16x8 bfr = *(const bf16x8*)(wsb + (size_t)(pb * 16 + fr) * 128 + ks * 32 + fq * 8);
            acc = __builtin_amdgcn_mfma_f32_16x16x32_bf16(af[ks], bfr, acc, 0, 0, 0); }
        const int row = row0 + pb * 16 + fr, cc = g * 128 + cblk * 16 + 4 * fq;
        const float bsv = bs[pb * 16 + fr];
        const u32x2 uu = *(const u32x2*)(z + (size_t)row * ZLD + OFF_U + cc), gg = *(const u32x2*)(z + (size_t)row * ZLD + OFF_GA + cc);
        u32x2 w; w.x = cvt_pk_bf16(bf_lo(uu.x) * (acc[0] + bsv) * bf_lo(gg.x), bf_hi(uu.x) * (acc[1] + bsv) * bf_hi(gg.x));
        w.y = cvt_pk_bf16(bf_lo(uu.y) * (acc[2] + bsv) * bf_lo(gg.y), bf_hi(uu.y) * (acc[3] + bsv) * bf_hi(gg.y));
        *(u32x2*)(ab + (size_t)row * 1024 + cc) = w;
    }
}

__device__ __forceinline__ void attn_task(const Params& p, int l, int task, int ctxq, int lane) {
    const int fr = lane & 15, fq = lane >> 4;
    const bf16_t* z = (const bf16_t*)(p.ws + O_Z);
    const bf16_t* vT = (const bf16_t*)(p.ws + O_VT);
    bf16_t* nb = (bf16_t*)(p.ws + O_NB);
    int b, h, r = 0, j = 0, qrow0;
    if (!ctxq) { j = task & 3; r = (task >> 2) & 31; h = (task >> 7) & 7; b = task >> 10; qrow0 = b * SEQ + r * 64 + j * 16; }
    else { const int qb = task & 15; h = (task >> 4) & 7; b = task >> 7; qrow0 = ML + b * CTX + qb * 16; }
    bf16x8 qf[4];
#pragma unroll
    for (int ks = 0; ks < 4; ++ks) qf[ks] = *(const bf16x8*)(z + (size_t)(qrow0 + fr) * ZLD + OFF_Q + h * 128 + ks * 32 + fq * 8);
    f32x4 o[8];
#pragma unroll
    for (int i = 0; i < 8; ++i) o[i] = (f32x4){0.f, 0.f, 0.f, 0.f};
    float mrun = -INFINITY, lrun = 0.f;
    const int rs = min(max(r - 4, 0), 24), band0 = min(max(j * 16 - 8, 0), 32);
    const int cq = j * 16 + fr, cstart = min(max(cq - 8, 0), 48);
    const float* rpb = p.rpb + (size_t)(l * 8 + h) * 15 * 31;
    const int nloc = ctxq ? 0 : 8;
    const int nsteps = nloc + 8;
    auto krow_of = [&](int step) { return (step < nloc) ? (b * SEQ + (rs + step) * 64 + band0) : (ML + b * CTX + (step - nloc) * 32); };
    const int kperm = 8 * (fr >> 2) + (fr & 3);
    bf16x8 kcur[2][4], knxt[2][4];
    { const int kr0 = krow_of(0);
#pragma unroll
      for (int kb = 0; kb < 2; ++kb)
#pragma unroll
        for (int ks = 0; ks < 4; ++ks) kcur[kb][ks] = *(const bf16x8*)(z + (size_t)(kr0 + kperm + 4 * kb) * ZLD + OFF_K + h * 128 + fq * 8 + ks * 32); }
    for (int step = 0; step < nsteps; ++step) {
        const bool loc = step < nloc;
        const int kr = rs + step;
        const int krow0 = krow_of(step);
        const bf16_t* vp = vT + (size_t)(h * 128 + fr) * MT + krow0 + 8 * fq;
        bf16x8 vv[8];
#pragma unroll
        for (int db = 0; db < 8; ++db) vv[db] = *(const bf16x8*)(vp + (size_t)(db * 16) * MT);
        { const int krn = krow_of(step + 1 < nsteps ? step + 1 : step);
#pragma unroll
          for (int kb = 0; kb < 2; ++kb)
#pragma unroll
            for (int ks = 0; ks < 4; ++ks) knxt[kb][ks] = *(const bf16x8*)(z + (size_t)(krn + kperm + 4 * kb) * ZLD + OFF_K + h * 128 + fq * 8 + ks * 32); }
        f32x4 st[2];
#pragma unroll
        for (int kb = 0; kb < 2; ++kb) { f32x4 a = {0.f, 0.f, 0.f, 0.f};
#pragma unroll
            for (int ks = 0; ks < 4; ++ks) a = __builtin_amdgcn_mfma_f32_16x16x32_bf16(kcur[kb][ks], qf[ks], a, 0, 0, 0);
            st[kb] = a; }
        if (loc) { const int dr = kr - r;
#pragma unroll
            for (int kb = 0; kb < 2; ++kb)
#pragma unroll
                for (int jj = 0; jj < 4; ++jj) { const int ckc = band0 + 8 * fq + 4 * kb + jj; const bool valid = (ckc >= cstart) && (ckc < cstart + 16);
                    const int dc = valid ? (ckc - cq) : 0; const float bias = rpb[(dr + 7) * 31 + dc + 15];
                    st[kb][jj] = valid ? st[kb][jj] + bias : -INFINITY; } }
        float mx = fmaxf(fmaxf(fmaxf(st[0][0], st[0][1]), fmaxf(st[0][2], st[0][3])), fmaxf(fmaxf(st[1][0], st[1][1]), fmaxf(st[1][2], st[1][3])));
        mx = fmaxf(mx, __shfl_xor(mx, 16)); mx = fmaxf(mx, __shfl_xor(mx, 32));
        const float mnew = fmaxf(mrun, mx);
        const float alpha = __expf(mrun - mnew);
        mrun = mnew;
        float pv[8]; float psum = 0.f;
#pragma unroll
        for (int kb = 0; kb < 2; ++kb)
#pragma unroll
            for (int jj = 0; jj < 4; ++jj) { const float e = __expf(st[kb][jj] - mnew); pv[kb * 4 + jj] = e; psum += e; }
        lrun = lrun * alpha + psum;
        u32x4 pw; pw.x = cvt_pk_bf16(pv[0], pv[1]); pw.y = cvt_pk_bf16(pv[2], pv[3]); pw.z = cvt_pk_bf16(pv[4], pv[5]); pw.w = cvt_pk_bf16(pv[6], pv[7]);
        const bf16x8 pf = __builtin_bit_cast(bf16x8, pw);
#pragma unroll
        for (int db = 0; db < 8; ++db) { o[db] = o[db] * alpha;
            o[db] = __builtin_amdgcn_mfma_f32_16x16x32_bf16(vv[db], pf, o[db], 0, 0, 0); }
#pragma unroll
        for (int kb = 0; kb < 2; ++kb)
#pragma unroll
            for (int ks = 0; ks < 4; ++ks) kcur[kb][ks] = knxt[kb][ks];
    }
    lrun += __shfl_xor(lrun, 16); lrun += __shfl_xor(lrun, 32);
    const float inv = 1.0f / lrun;
    const size_t row = (size_t)(qrow0 + fr);
#pragma unroll
    for (int db = 0; db < 8; ++db) { const int cc = h * 128 + db * 16 + 4 * fq;
        const u32x2 gg = *(const u32x2*)(z + row * ZLD + OFF_GN + cc);
        u32x2 w; w.x = cvt_pk_bf16(o[db][0] * inv * bf_lo(gg.x), o[db][1] * inv * bf_hi(gg.x)); w.y = cvt_pk_bf16(o[db][2] * inv * bf_lo(gg.y), o[db][3] * inv * bf_hi(gg.y));
        *(u32x2*)(nb + row * 1024 + cc) = w; }
}

#ifndef PM
#define PM 0xFFFF
#endif
#define XB_CNT(j) (64 * (j))
#define XB_SUB(j) (1024 + 64 * (j))
#define XB_TOP 2048
#define XB_ALL 2112
#define XB_BYTES 16384
__device__ __forceinline__ unsigned xb_ld(unsigned* p) { return __hip_atomic_load(p, __ATOMIC_RELAXED, __HIP_MEMORY_SCOPE_AGENT); }
__device__ __forceinline__ unsigned xb_add(unsigned* p, unsigned v) { return __hip_atomic_fetch_add(p, v, __ATOMIC_RELAXED, __HIP_MEMORY_SCOPE_AGENT); }
__device__ __forceinline__ void grid_barrier(unsigned* bar, unsigned epoch, volatile unsigned* bs) {
    int t_ = threadIdx.x; asm volatile("" : "+v"(t_));
    const int lane = t_ & 63, wave = __builtin_amdgcn_readfirstlane(t_ >> 6);
    asm volatile("s_waitcnt vmcnt(0)" ::: "memory");
    if (lane == 0) atomicAdd((unsigned*)&bs[0], 1u);
    if (wave == 0) {
        bool lastx = false;
        if (lane == 0) { while (bs[0] < 8u * epoch) __builtin_amdgcn_s_sleep(1);
            const unsigned old = xb_add(&bar[XB_SUB(bs[4])], 1u); lastx = (old + 1u == bs[2] * epoch); }
        lastx = __builtin_amdgcn_readfirstlane(lastx ? 1 : 0) != 0;
        if (lastx) {
            __builtin_amdgcn_fence(__ATOMIC_RELEASE, "agent");
            asm volatile("s_waitcnt vmcnt(0)" ::: "memory");
            if (lane == 0) xb_add(&bar[XB_TOP], 1u);
        }
        if (lane == 0) { const unsigned need = bs[3] * epoch; while (xb_ld(&bar[XB_TOP]) < need) __builtin_amdgcn_s_sleep(8); }
        __builtin_amdgcn_fence(__ATOMIC_ACQUIRE, "agent");
        asm volatile("s_waitcnt vmcnt(0)" ::: "memory");
        if (lane == 0) bs[1] = epoch;
    }
    while (bs[1] < epoch) __builtin_amdgcn_s_sleep(4);
    asm volatile("" ::: "memory");
}
__device__ __forceinline__ void grid_barrier_setup(unsigned* bar, volatile unsigned* bs) {
    if (threadIdx.x == 0) {
        const unsigned x = (unsigned)__builtin_amdgcn_s_getreg((3 << 11) | 20) & 0xFu;
        bs[0] = 0u; bs[1] = 0u; bs[4] = x;
        xb_add(&bar[XB_CNT(x)], 1u);
        xb_add(&bar[XB_ALL], 1u);
        while (xb_ld(&bar[XB_ALL]) < gridDim.x) __builtin_amdgcn_s_sleep(8);
        unsigned nx = 0u; for (int j = 0; j < 16; ++j) nx += (xb_ld(&bar[XB_CNT(j)]) != 0u) ? 1u : 0u;
        bs[2] = xb_ld(&bar[XB_CNT(x)]); bs[3] = nx;
    }
    __syncthreads();
}
#define GSYNCN(e) do { grid_barrier((unsigned*)(p.ws + WS_TOTAL), (unsigned)(e), blk_sync); } while (0)
__device__ __forceinline__ void gmlp_task2(const Params& p, int l, int task, int lane) {
    const int fr = lane & 15, fq = lane >> 4;
    const int cb = task & 3, g = (task >> 2) & 7, ck = task >> 5;
    const int row0 = ck * 128;
    const bf16_t* vgT = (const bf16_t*)(p.ws + O_VGT);
    const float* stats = (const float*)(p.ws + O_STATS);
    const bf16_t* wsb = (const bf16_t*)(p.ws + O_WSB) + (size_t)(l * 8 + g) * 128 * 128;
    const bf16_t* z = (const bf16_t*)(p.ws + O_Z);
    bf16_t* ab = (bf16_t*)(p.ws + O_AB);
    const int chb = g * 128 + cb * 32 + 8 * (fr >> 2) + (fr & 3);
    bf16x8 af[2][4];
#pragma unroll
    for (int ks = 0; ks < 4; ++ks) { const int q0 = ks * 32 + fq * 8;
        const float* st = stats + (size_t)(row0 + q0) * 2;
        const f32x4 s0 = *(const f32x4*)st, s1 = *(const f32x4*)(st + 4), s2 = *(const f32x4*)(st + 8), s3 = *(const f32x4*)(st + 12);
#pragma unroll
        for (int kb = 0; kb < 2; ++kb) { const int ch = chb + 4 * kb;
            const float lg = p.ln_g[l * 1024 + ch], lb = p.ln_b[l * 1024 + ch];
            const u32x4 raw = *(const u32x4*)(vgT + (size_t)ch * MT + row0 + q0);
            const float e0 = (bf_lo(raw.x) - s0[0]) * s0[1] * lg + lb, e1 = (bf_hi(raw.x) - s0[2]) * s0[3] * lg + lb;
            const float e2 = (bf_lo(raw.y) - s1[0]) * s1[1] * lg + lb, e3 = (bf_hi(raw.y) - s1[2]) * s1[3] * lg + lb;
            const float e4 = (bf_lo(raw.z) - s2[0]) * s2[1] * lg + lb, e5 = (bf_hi(raw.z) - s2[2]) * s2[3] * lg + lb;
            const float e6 = (bf_lo(raw.w) - s3[0]) * s3[1] * lg + lb, e7 = (bf_hi(raw.w) - s3[2]) * s3[3] * lg + lb;
            u32x4 w; w.x = cvt_pk_bf16(e0, e1); w.y = cvt_pk_bf16(e2, e3); w.z = cvt_pk_bf16(e4, e5); w.w = cvt_pk_bf16(e6, e7);
            af[kb][ks] = __builtin_bit_cast(bf16x8, w); } }
    const float* bs = p.gbs + (l * 8 + g) * 128;
#pragma unroll 2
    for (int pb = 0; pb < 8; ++pb) {
        f32x4 acc0 = {0.f, 0.f, 0.f, 0.f}, acc1 = {0.f, 0.f, 0.f, 0.f};
#pragma unroll
        for (int ks = 0; ks < 4; ++ks) { const bf16x8 bfr = *(const bf16x8*)(wsb + (size_t)(pb * 16 + fr) * 128 + ks * 32 + fq * 8);
            acc0 = __builtin_amdgcn_mfma_f32_16x16x32_bf16(af[0][ks], bfr, acc0, 0, 0, 0);
            acc1 = __builtin_amdgcn_mfma_f32_16x16x32_bf16(af[1][ks], bfr, acc1, 0, 0, 0); }
        const int row = row0 + pb * 16 + fr, cc = g * 128 + cb * 32 + 8 * fq;
        const float bsv = bs[pb * 16 + fr];
        const u32x4 uu = *(const u32x4*)(z + (size_t)row * ZLD + OFF_U + cc), gg = *(const u32x4*)(z + (size_t)row * ZLD + OFF_GA + cc);
        u32x4 w;
        w.x = cvt_pk_bf16(bf_lo(uu.x) * (acc0[0] + bsv) * bf_lo(gg.x), bf_hi(uu.x) * (acc0[1] + bsv) * bf_hi(gg.x));
        w.y = cvt_pk_bf16(bf_lo(uu.y) * (acc0[2] + bsv) * bf_lo(gg.y), bf_hi(uu.y) * (acc0[3] + bsv) * bf_hi(gg.y));
        w.z = cvt_pk_bf16(bf_lo(uu.z) * (acc1[0] + bsv) * bf_lo(gg.z), bf_hi(uu.z) * (acc1[1] + bsv) * bf_hi(gg.z));
        w.w = cvt_pk_bf16(bf_lo(uu.w) * (acc1[2] + bsv) * bf_lo(gg.w), bf_hi(uu.w) * (acc1[3] + bsv) * bf_hi(gg.w));
        *(u32x4*)(ab + (size_t)row * 1024 + cc) = w;
    }
}

__device__ __forceinline__ void attn_task2(const Params& p, int l, int task, int lane) {
    const int fr = lane & 15, fq = lane >> 4;
    const bf16_t* z = (const bf16_t*)(p.ws + O_Z);
    const bf16_t* vT = (const bf16_t*)(p.ws + O_VT);
    bf16_t* nb = (bf16_t*)(p.ws + O_NB);
    const int j = task & 3, rp = (task >> 2) & 15, h = (task >> 6) & 7, b = task >> 9;
    const int r0 = 2 * rp;
    const int qrow0 = b * SEQ + r0 * 64 + j * 16;
    bf16x8 qf[2][4];
#pragma unroll
    for (int qi = 0; qi < 2; ++qi)
#pragma unroll
        for (int ks = 0; ks < 4; ++ks) qf[qi][ks] = *(const bf16x8*)(z + (size_t)(qrow0 + qi * 64 + fr) * ZLD + OFF_Q + h * 128 + ks * 32 + fq * 8);
    f32x4 o[2][8];
#pragma unroll
    for (int qi = 0; qi < 2; ++qi)
#pragma unroll
        for (int i = 0; i < 8; ++i) o[qi][i] = (f32x4){0.f, 0.f, 0.f, 0.f};
    float mrun[2] = {-INFINITY, -INFINITY}, lrun[2] = {0.f, 0.f};
    const int rsA = min(max(r0 - 4, 0), 24), rsB = min(max(r0 - 3, 0), 24);
    const int nloc = rsB + 8 - rsA;
    const int band0 = min(max(j * 16 - 8, 0), 32);
    const int cq = j * 16 + fr, cstart = min(max(cq - 8, 0), 48);
    const float* rpb = p.rpb + (size_t)(l * 8 + h) * 15 * 31;
    const int nsteps = nloc + 8;
    const int kperm = 8 * (fr >> 2) + (fr & 3);
    auto krow_of = [&](int step) { return (step < nloc) ? (b * SEQ + (rsA + step) * 64 + band0) : (ML + b * CTX + (step - nloc) * 32); };
    bf16x8 kcur[2][4];
    { const int kr0_ = krow_of(0);
#pragma unroll
      for (int kb = 0; kb < 2; ++kb)
#pragma unroll
        for (int ks = 0; ks < 4; ++ks) kcur[kb][ks] = *(const bf16x8*)(z + (size_t)(kr0_ + kperm + 4 * kb) * ZLD + OFF_K + h * 128 + fq * 8 + ks * 32); }
    for (int step = 0; step < nsteps; ++step) {
        const bool loc = step < nloc;
        const int kr = rsA + step;
        const int krow0 = krow_of(step);
        const bool act0 = !loc || (kr >= rsA && kr < rsA + 8), act1 = !loc || (kr >= rsB && kr < rsB + 8);
        bf16x8 knxt[2][4];
        { const int krn = krow_of(step + 1 < nsteps ? step + 1 : step);
#pragma unroll
          for (int kb = 0; kb < 2; ++kb)
#pragma unroll
            for (int ks = 0; ks < 4; ++ks) knxt[kb][ks] = *(const bf16x8*)(z + (size_t)(krn + kperm + 4 * kb) * ZLD + OFF_K + h * 128 + fq * 8 + ks * 32); }
        f32x4 st[2][2];
#pragma unroll
        for (int qi = 0; qi < 2; ++qi)
#pragma unroll
            for (int kb = 0; kb < 2; ++kb) { f32x4 a_ = {0.f, 0.f, 0.f, 0.f};
#pragma unroll
                for (int ks = 0; ks < 4; ++ks) a_ = __builtin_amdgcn_mfma_f32_16x16x32_bf16(kcur[kb][ks], qf[qi][ks], a_, 0, 0, 0);
                st[qi][kb] = a_; }
        const bf16_t* vp = vT + (size_t)(h * 128 + fr) * MT + krow0 + 8 * fq;
        bf16x8 vv[8];
#pragma unroll
        for (int db = 0; db < 8; ++db) vv[db] = *(const bf16x8*)(vp + (size_t)(db * 16) * MT);
#pragma unroll
        for (int qi = 0; qi < 2; ++qi) {
            const bool active = qi ? act1 : act0;
            if (active) {
                if (loc) { const int dr = kr - (r0 + qi);
#pragma unroll
                    for (int kb = 0; kb < 2; ++kb)
#pragma unroll
                        for (int jj = 0; jj < 4; ++jj) { const int ckc = band0 + 8 * fq + 4 * kb + jj; const bool valid = (ckc >= cstart) && (ckc < cstart + 16);
                            const int dc = valid ? (ckc - cq) : 0; const float bias = rpb[(dr + 7) * 31 + dc + 15];
                            st[qi][kb][jj] = valid ? st[qi][kb][jj] + bias : -INFINITY; } }
                float mx = fmaxf(fmaxf(fmaxf(st[qi][0][0], st[qi][0][1]), fmaxf(st[qi][0][2], st[qi][0][3])), fmaxf(fmaxf(st[qi][1][0], st[qi][1][1]), fmaxf(st[qi][1][2], st[qi][1][3])));
                mx = fmaxf(mx, __shfl_xor(mx, 16)); mx = fmaxf(mx, __shfl_xor(mx, 32));
                const float mnew = fmaxf(mrun[qi], mx);
                const float alpha = __expf(mrun[qi] - mnew);
                mrun[qi] = mnew;
                float pv[8]; float psum = 0.f;
#pragma unroll
                for (int kb = 0; kb < 2; ++kb)
#pragma unroll
                    for (int jj = 0; jj < 4; ++jj) { const float e = __expf(st[qi][kb][jj] - mnew); pv[kb * 4 + jj] = e; psum += e; }
                lrun[qi] = lrun[qi] * alpha + psum;
                u32x4 pw; pw.x = cvt_pk_bf16(pv[0], pv[1]); pw.y = cvt_pk_bf16(pv[2], pv[3]); pw.z = cvt_pk_bf16(pv[4], pv[5]); pw.w = cvt_pk_bf16(pv[6], pv[7]);
                const bf16x8 pf = __builtin_bit_cast(bf16x8, pw);
#pragma unroll
                for (int db = 0; db < 8; ++db) { o[qi][db] = o[qi][db] * alpha;
                    o[qi][db] = __builtin_amdgcn_mfma_f32_16x16x32_bf16(vv[db], pf, o[qi][db], 0, 0, 0); }
            }
        }
#pragma unroll
        for (int kb = 0; kb < 2; ++kb)
#pragma unroll
            for (int ks = 0; ks < 4; ++ks) kcur[kb][ks] = knxt[kb][ks];
    }
#pragma unroll
    for (int qi = 0; qi < 2; ++qi) {
        float lr = lrun[qi]; lr += __shfl_xor(lr, 16); lr += __shfl_xor(lr, 32);
        const float inv = 1.0f / lr;
        const size_t row = (size_t)(qrow0 + qi * 64 + fr);
#pragma unroll
        for (int db = 0; db < 8; ++db) { const int cc = h * 128 + db * 16 + 4 * fq;
            const u32x2 gg = *(const u32x2*)(z + row * ZLD + OFF_GN + cc);
            u32x2 w; w.x = cvt_pk_bf16(o[qi][db][0] * inv * bf_lo(gg.x), o[qi][db][1] * inv * bf_hi(gg.x)); w.y = cvt_pk_bf16(o[qi][db][2] * inv * bf_lo(gg.y), o[qi][db][3] * inv * bf_hi(gg.y));
            *(u32x2*)(nb + row * 1024 + cc) = w; }
    }
}

template <int PH> __device__ __forceinline__ void do_phase(const Params& p, const int l, unsigned char* smem) {
    LAS unsigned char* lds = (LAS unsigned char*)smem;
    const int bid = blockIdx.x, G = gridDim.x;
    char* ws = p.ws;
    const int last = (l == 1);
    const float* xin = last ? (const float*)p.out : p.x;
    const float* cin = last ? (const float*)(ws + O_C1) : p.ctx;
    float* xout = p.out;
    float* cout = (float*)(ws + O_C1);
    if (PH == 0) { phase0(p, smem); }
    if (PH == 1) {
        phase_norm(p, l, xin, cin);
        if (last) { __syncthreads(); for (int t = bid; t < (D / 64) * (WIN / 256); t += G) transpose_tile(p.w_in + (size_t)D * WIN, (bf16_t*)(ws + O_WINT), D, WIN, t, smem); }
    }
    if (PH == 2) {
        SchedMain S; S.h = ws + O_H; S.wt = ws + O_WINT; S.nM = last ? 64 : 72; S.extra = last ? 64 : 0; S.G = G; S.c = bid;
        EpiMain E; E.z = (bf16_t*)(ws + O_Z); E.vgT = (bf16_t*)(ws + O_VGT); E.vT = (bf16_t*)(ws + O_VT);
        gemm_phase(lds, D, D, D, S, E);
    }
    if (PH == 3) {
        { SchedF1 S; S.dft = ws + O_DFTC; S.z = ws + O_Z; S.nunits = (last ? 64 : 72) * 8; S.G = G; S.c = bid;
          EpiF1 E; E.TT = (bf16_t*)(ws + O_TT); E.TTc = (bf16_t*)(ws + O_TTC);
          gemm_phase(lds, 256, ZLD, 256, S, E); }
        phase_qknorm(p, l, last);
        __syncthreads();
        phase_lnstats(p, last ? ML : MT, smem);
    }
    if (PH == 4) {
        { SchedF2 S; S.cs = ws + O_CSN; S.tt = ws + O_TT; S.nunits = 256; S.ctxmode = 0; S.G = G; S.c = bid;
          EpiF2 E; E.z = (const bf16_t*)(ws + O_Z); E.fb = (bf16_t*)(ws + O_FB); E.ctxmode = 0; E.scale = 0.001381067932f;
          gemm_phase(lds, 4096, 4096, 4096, S, E); }
        if (!last) {
            SchedF2 S; S.cs = ws + O_CSC; S.tt = ws + O_TTC; S.nunits = 32; S.ctxmode = 1; S.G = G; S.c = (bid + 128) % G;
            EpiF2 E; E.z = (const bf16_t*)(ws + O_Z); E.fb = (bf16_t*)(ws + O_FB); E.ctxmode = 1; E.scale = 0.00390625f;
            gemm_phase(lds, 512, 512, 512, S, E);
        }
        {
            const int ngm = (last ? ML : MT) / 128 * 32;
            int tid_ = threadIdx.x; asm volatile("" : "+v"(tid_));
            const int lane = tid_ & 63, gw = bid * 8 + __builtin_amdgcn_readfirstlane(tid_ >> 6), nw = G * 8;
            for (int t = gw; t < ngm; t += nw) gmlp_task2(p, l, t, lane);
            for (int t = gw; t < 4096; t += nw) attn_task2(p, l, t, lane);
            if (!last) for (int t = gw; t < 1024; t += nw) attn_task(p, l, t, 1, lane);
        }
    }
    if (PH == 5) {
        SchedMerge S; S.ab = ws + O_AB; S.wp = ws + O_WPT + (size_t)l * 3 * SZ_WPT; S.ntiles = (last ? 64 : 72) * 8; S.G = G; S.c = bid;
        EpiMerge E; E.z = (const bf16_t*)(ws + O_Z); E.y = (bf16_t*)(ws + O_Y);
        gemm_phase(lds, 1024, 1024, 1024, S, E);
    }
    if (PH == 6) {
        SchedOut S; S.y = ws + O_Y; S.wo = ws + O_WOT + (size_t)l * SZ_WOT; S.ntiles = (last ? 64 : 72) * 8; S.G = G; S.c = bid;
        EpiOut E; E.xin = xin; E.cin = cin; E.xout = xout; E.cout = cout; E.mod = (const float*)(ws + O_MOD) + (size_t)l * 9 * 6144;
        gemm_phase(lds, D, D, D, S, E);
    }
}

#ifndef MULTI_LAUNCH
#define MULTI_LAUNCH 0
#endif
#if MULTI_LAUNCH
template <int PH> __global__ void __launch_bounds__(512, 2) k_phase(Params p, int l) {
    __shared__ __attribute__((aligned(16))) unsigned char smem[STAGE_BYTES];
    do_phase<PH>(p, l, smem);
}
#else
__global__ void __launch_bounds__(512, 2) fwd_megakernel(Params p) {
    __shared__ __attribute__((aligned(1024))) unsigned char smem[STAGE_BYTES + 32];
    unsigned* blk_sync = (unsigned*)(smem + STAGE_BYTES);
    cg::grid_group grid = cg::this_grid();
    grid_barrier_setup((unsigned*)(p.ws + WS_TOTAL), blk_sync);
    do_phase<0>(p, 0, smem);
    GSYNCN(1);
#pragma unroll 1
    for (int l = 0; l < 2; ++l) {
        do_phase<1>(p, l, smem); GSYNCN(1 + 6 * l + 1);
        do_phase<2>(p, l, smem); GSYNCN(1 + 6 * l + 2);
        do_phase<3>(p, l, smem); GSYNCN(1 + 6 * l + 3);
        do_phase<4>(p, l, smem); GSYNCN(1 + 6 * l + 4);
        do_phase<5>(p, l, smem); GSYNCN(1 + 6 * l + 5);
        do_phase<6>(p, l, smem); if (l == 0) GSYNCN(1 + 6 * l + 6);
    }
    grid.sync();
}
#endif

extern "C" void kernel_launch(void* const* d_in, const int* in_sizes, int n_in, void* d_out, int out_size, void* d_ws, size_t ws_size, hipStream_t stream) {
    static int grid_blocks = 0;
    if (!grid_blocks) {
        int dev = 0, cus = 0, per_cu = 0;
        hipGetDevice(&dev);
        hipDeviceGetAttribute(&cus, hipDeviceAttributeMultiprocessorCount, dev);
        grid_blocks = cus;
    }
    if (ws_size < WS_TOTAL + XB_BYTES) { fprintf(stderr, "workspace too small: %zu < %zu\n", ws_size, (size_t)WS_TOTAL); return; }
    Params p{};
    const float* const* in = (const float* const*)d_in;
    p.x = in[0]; p.c = in[1]; p.ctx = in[2]; p.c_ctx = in[3]; p.norm_g = in[4]; p.w_ada = in[5]; p.b_ada = in[6]; p.w_in = in[7]; p.ln_g = in[8]; p.ln_b = in[9];
    p.gws = in[10]; p.gbs = in[11]; p.qg = in[12]; p.kg = in[13]; p.rpb = in[14]; p.w_pa = in[15]; p.w_pf = in[16]; p.w_pn = in[17]; p.w_out = in[18];
    p.out = (float*)d_out; p.ws = (char*)d_ws;
#if MULTI_LAUNCH
    const dim3 g(256), b(512);
    k_phase<0><<<g, b, 0, stream>>>(p, 0);
    for (int l = 0; l < 2; ++l) {
        k_phase<1><<<g, b, 0, stream>>>(p, l); k_phase<2><<<g, b, 0, stream>>>(p, l); k_phase<3><<<g, b, 0, stream>>>(p, l);
        k_phase<4><<<g, b, 0, stream>>>(p, l); k_phase<5><<<g, b, 0, stream>>>(p, l); k_phase<6><<<g, b, 0, stream>>>(p, l);
    }
#else
    hipMemsetAsync((char*)d_ws + WS_TOTAL, 0, XB_BYTES, stream);
    void* args[] = {&p};
    hipError_t e = hipLaunchCooperativeKernel((void*)fwd_megakernel, dim3(grid_blocks), dim3(512), args, 0, stream);
    if (e != hipSuccess) fprintf(stderr, "cooperative launch failed: %s (grid %d)\n", hipGetErrorString(e), grid_blocks);
#endif
}
```

```cpp
#include <hip/hip_runtime.h>
#include <hip/hip_cooperative_groups.h>
#include <cstdio>
namespace cg = cooperative_groups;

#define LAS __attribute__((address_space(3)))
typedef unsigned short bf16_t;
typedef short bf16x8 __attribute__((ext_vector_type(8)));
typedef float f32x4 __attribute__((ext_vector_type(4)));
typedef float f32x2 __attribute__((ext_vector_type(2)));
typedef unsigned u32x4 __attribute__((ext_vector_type(4)));
typedef unsigned u32x2 __attribute__((ext_vector_type(2)));

constexpr int D = 2048, NB = 8, SEQ = 2048, CTX = 256, WIN = 15360;
constexpr int ML = NB * SEQ, MC = NB * CTX, MT = ML + MC;
constexpr int ZLD = 13312, OFF_U = 0, OFF_GA = 1024, OFF_F = 2048, OFF_GF = 3072, OFF_Q = 4096, OFF_K = 5120, OFF_GN = 6144, OFF_MERGE = 7168;
constexpr float EPS = 1e-6f;

constexpr size_t SZ_WINT = (size_t)WIN * D * 2, SZ_WPT = (size_t)D * 1024 * 2, SZ_WOT = (size_t)D * D * 2, SZ_WSB = (size_t)8 * 128 * 128 * 2;
constexpr size_t O_WINT = 0;
constexpr size_t O_WPT = O_WINT + SZ_WINT;
constexpr size_t O_WOT = O_WPT + 6 * SZ_WPT;
constexpr size_t O_WSB = O_WOT + 2 * SZ_WOT;
constexpr size_t O_MOD = O_WSB + 2 * SZ_WSB;
constexpr size_t O_DFTC = O_MOD + (size_t)2 * 9 * 6144 * 4;
constexpr size_t O_CSN = O_DFTC + (size_t)512 * 256 * 2;
constexpr size_t O_CSC = O_CSN + (size_t)2048 * 4096 * 2;
constexpr size_t O_H = O_CSC + (size_t)256 * 512 * 2;
constexpr size_t O_TT = O_H;
constexpr size_t O_TTC = O_TT + (size_t)32 * 256 * 4096 * 2;
constexpr size_t O_Y = O_H;
constexpr size_t O_Z = O_H + (size_t)MT * D * 2;
constexpr size_t O_VGT = O_Z + (size_t)MT * ZLD * 2;
constexpr size_t O_VT = O_VGT + (size_t)1024 * MT * 2;
constexpr size_t O_STATS = O_VT + (size_t)1024 * MT * 2;
constexpr size_t O_AB = O_STATS + (size_t)MT * 2 * 4;
constexpr size_t O_FB = O_AB + (size_t)MT * 1024 * 2;
constexpr size_t O_NB = O_FB + (size_t)MT * 1024 * 2;
constexpr size_t O_C1 = O_NB + (size_t)MT * 1024 * 2;
constexpr size_t WS_TOTAL = O_C1 + (size_t)MC * D * 4;
static_assert(WS_TOTAL <= (size_t)1006632960, "workspace budget");
static_assert((size_t)32 * 256 * 4096 * 2 + (size_t)32 * 256 * 512 * 2 <= (size_t)MT * D * 2, "TT alias");

struct Params {
    const float *x, *c, *ctx, *c_ctx, *norm_g, *w_ada, *b_ada, *w_in, *ln_g, *ln_b, *gws, *gbs, *qg, *kg, *rpb, *w_pa, *w_pf, *w_pn, *w_out;
    float* out;
    char* ws;
};

__device__ __forceinline__ unsigned cvt_pk_bf16(float lo, float hi) { unsigned r; asm volatile("v_cvt_pk_bf16_f32 %0, %1, %2" : "=v"(r) : "v"(lo), "v"(hi)); return r; }
__device__ __forceinline__ float bf_lo(unsigned u) { return __uint_as_float(u << 16); }
__device__ __forceinline__ float bf_hi(unsigned u) { return __uint_as_float(u & 0xffff0000u); }
__device__ __forceinline__ float bf2f(bf16_t b) { return __uint_as_float(((unsigned)b) << 16); }
__device__ __forceinline__ float sigmoid_f(float v) { return __builtin_amdgcn_rcpf(1.0f + __expf(-v)); }
__device__ __forceinline__ float silu_f(float v) { return v * sigmoid_f(v); }
__device__ __forceinline__ float gelu_f(float v) { const float u = 1.5957691216f * (v + 0.044715f * v * v * v); return v * sigmoid_f(u); }
template <int ACT> __device__ __forceinline__ float act_f(float v) {
    if (ACT == 1) return gelu_f(v);
    if (ACT == 2) return silu_f(v);
    if (ACT == 3) return sigmoid_f(v);
    return v;
}

constexpr int BM = 256, BK = 64, HALF = 128, HTB = HALF * BK * 2, STAGE_BYTES = 8 * HTB, NXCD = 8, WGM = 8;
__device__ __forceinline__ int lds_byte(int r, int c) { const int st = (r >> 4) * 2 + (c >> 5), rr = r & 15, cc = c & 31, ob = rr * 64 + cc * 2; return st * 1024 + (ob ^ (((ob >> 9) & 1) << 5)); }
__device__ __forceinline__ void stage_rc(int b, int& R, int& C) { const int st = b / 1024, sb = b % 1024, swz = sb ^ (((sb >> 9) & 1) << 5); R = (st >> 1) * 16 + swz / 64; C = (st & 1) * 32 + (swz % 64) / 2; }
__device__ __forceinline__ int perm32(int rho) { const int n = rho >> 4, i = rho & 15; return 8 * (i >> 2) + 4 * n + (i & 3); }

struct Unit { const char* a; const char* b; int pm, pn, kind; };

template <class Epi, class Sched>
__device__ __forceinline__ void gemm_phase(LAS unsigned char* lds, const int lda, const int ldb, const int K, const Sched& S, const Epi& E) {
    int tid_ = threadIdx.x; asm volatile("" : "+v"(tid_));
    const int tid = tid_, wid = __builtin_amdgcn_readfirstlane(tid >> 6), lane = tid & 63, wr = wid >> 2, wc = wid & 3, fr = lane & 15, fq = lane >> 4;
    const int nt = K / BK;
    unsigned voffA[2], voffB[2];
#pragma unroll
    for (int i = 0; i < 2; ++i) { int R, C; stage_rc(tid * 16 + i * 8192, R, C); const int Rb = (R & ~31) + perm32(R & 31);
        voffA[i] = (unsigned)(R * lda + C) * 2u; voffB[i] = (unsigned)(Rb * ldb + C) * 2u; }
    const size_t kstep = (size_t)(BK * 2);
    const size_t hstepA = (size_t)HALF * lda * 2, hstepB = (size_t)HALF * ldb * 2;
    const unsigned ldsw = (unsigned)wid * 1024u;
    const int aoff = lds_byte(wr * 64 + fr, fq * 8), boff = lds_byte(wc * 32 + fr, fq * 8);
#define PG8_SA(b, h) (((b) * 2 + (h)) * HTB)
#define PG8_SB(b, h) ((4 + (b) * 2 + (h)) * HTB)
#define PG8_STAGE(bufoff, gbase, voff) do { _Pragma("unroll") for (int _i = 0; _i < 2; ++_i) \
        __builtin_amdgcn_global_load_lds((const unsigned*)((const char*)(gbase) + (voff)[_i]), (LAS unsigned*)(lds + (bufoff) + ldsw + _i * 8192), 16, 0, 0); } while (0)
#define PG8_LDA(dst, b, h) do { _Pragma("unroll") for (int m = 0; m < 4; ++m) _Pragma("unroll") for (int k = 0; k < 2; ++k) dst[m][k] = *(const LAS bf16x8*)(lds + PG8_SA(b, h) + aoff + m * 2048 + k * 1024); } while (0)
#define PG8_LDB(dst, b, h) do { _Pragma("unroll") for (int n = 0; n < 2; ++n) _Pragma("unroll") for (int k = 0; k < 2; ++k) dst[n][k] = *(const LAS bf16x8*)(lds + PG8_SB(b, h) + boff + n * 2048 + k * 1024); } while (0)
#define PG8_MMA(ai, bj, At, Bt) do { __builtin_amdgcn_s_setprio(1); _Pragma("unroll") for (int m = 0; m < 4; ++m) _Pragma("unroll") for (int n = 0; n < 2; ++n) _Pragma("unroll") for (int k = 0; k < 2; ++k) \
        acc[ai][bj][m][n] = __builtin_amdgcn_mfma_f32_16x16x32_bf16(Bt[n][k], At[m][k], acc[ai][bj][m][n], 0, 0, 0); __builtin_amdgcn_s_setprio(0); } while (0)
#define PG8_WAIT_V(n) asm volatile("s_waitcnt vmcnt(" #n ")" ::: "memory")
#define PG8_WAIT_L(n) asm volatile("s_waitcnt lgkmcnt(" #n ")" ::: "memory")
#define PG8_BAR __builtin_amdgcn_s_barrier()
#define PG8_SCHED __builtin_amdgcn_sched_barrier(0)
    Unit cur, nxt; int ui = 0;
    if (!S.next(0, cur)) return;
    f32x4 acc[2][2][4][2];
#pragma unroll
    for (int a = 0; a < 2; ++a)
#pragma unroll
        for (int b = 0; b < 2; ++b)
#pragma unroll
            for (int m = 0; m < 4; ++m)
#pragma unroll
                for (int n = 0; n < 2; ++n) acc[a][b][m][n] = (f32x4){0.f, 0.f, 0.f, 0.f};
    bf16x8 At[4][2], B0[2][2], B1[2][2];
    const char* cA = cur.a; const char* cB = cur.b;
    PG8_STAGE(PG8_SB(0, 0), cB, voffB); PG8_STAGE(PG8_SA(0, 0), cA, voffA); PG8_STAGE(PG8_SB(0, 1), cB + hstepB, voffB); PG8_STAGE(PG8_SA(0, 1), cA + hstepA, voffA);
    if (wr == 1) PG8_BAR;
    PG8_WAIT_V(4); PG8_BAR;
    PG8_STAGE(PG8_SB(1, 0), cB + kstep, voffB); PG8_STAGE(PG8_SA(1, 0), cA + kstep, voffA); PG8_STAGE(PG8_SB(1, 1), cB + hstepB + kstep, voffB);
    PG8_WAIT_V(6); PG8_BAR;
#pragma unroll 1
    for (;;) {
        const bool has_next = S.next(ui + 1, nxt);
        const char* nA = has_next ? nxt.a : cA; const char* nB = has_next ? nxt.b : cB;
#pragma unroll 1
        for (int t = 0; t < nt; t += 2) {
            const bool last = (t == nt - 2);
            const char* a1 = cA + (size_t)(t + 1) * kstep;
            const char* a2 = last ? nA : cA + (size_t)(t + 2) * kstep; const char* b2 = last ? nB : cB + (size_t)(t + 2) * kstep;
            const char* a3 = a2 + kstep; const char* b3 = b2 + kstep;
            PG8_LDB(B0, 0, 0); PG8_SCHED; PG8_LDA(At, 0, 0); PG8_STAGE(PG8_SA(1, 1), a1 + hstepA, voffA);
            PG8_WAIT_L(8); PG8_BAR; PG8_WAIT_L(0); PG8_MMA(0, 0, At, B0); PG8_BAR; PG8_SCHED;
            PG8_LDB(B1, 0, 1); PG8_STAGE(PG8_SB(0, 0), b2, voffB);
            PG8_BAR; PG8_WAIT_L(0); PG8_MMA(0, 1, At, B1); PG8_BAR;
            PG8_LDA(At, 0, 1); PG8_STAGE(PG8_SA(0, 0), a2, voffA);
            PG8_BAR; PG8_WAIT_L(0); PG8_MMA(1, 0, At, B0); PG8_BAR; PG8_SCHED;
            PG8_STAGE(PG8_SB(0, 1), b2 + hstepB, voffB);
            PG8_WAIT_V(6); PG8_BAR; PG8_MMA(1, 1, At, B1); PG8_BAR;
            PG8_LDB(B0, 1, 0); PG8_SCHED; PG8_LDA(At, 1, 0); PG8_STAGE(PG8_SA(0, 1), a2 + hstepA, voffA);
            PG8_WAIT_L(8); PG8_BAR; PG8_WAIT_L(0); PG8_MMA(0, 0, At, B0); PG8_BAR; PG8_SCHED;
            PG8_LDB(B1, 1, 1); PG8_STAGE(PG8_SB(1, 0), b3, voffB);
            PG8_BAR; PG8_WAIT_L(0); PG8_MMA(0, 1, At, B1); PG8_BAR;
            PG8_LDA(At, 1, 1); PG8_STAGE(PG8_SA(1, 0), a3, voffA);
            PG8_BAR; PG8_WAIT_L(0); PG8_MMA(1, 0, At, B0); PG8_BAR; PG8_SCHED;
            PG8_STAGE(PG8_SB(1, 1), b3 + hstepB, voffB);
            PG8_WAIT_V(6); PG8_BAR; PG8_MMA(1, 1, At, B1); PG8_BAR;
        }
        const bool keep = E(acc, cur, wr, wc, fr, fq);
        if (!has_next) break;
        if (!keep) {
#pragma unroll
            for (int a = 0; a < 2; ++a)
#pragma unroll
                for (int b = 0; b < 2; ++b)
#pragma unroll
                    for (int m = 0; m < 4; ++m)
#pragma unroll
                        for (int n = 0; n < 2; ++n) acc[a][b][m][n] = (f32x4){0.f, 0.f, 0.f, 0.f};
        }
        cur = nxt; cA = nA; cB = nB; ++ui;
    }
    PG8_WAIT_V(0);
    if (wr == 0) PG8_BAR;
    PG8_BAR;
#undef PG8_SA
#undef PG8_SB
#undef PG8_STAGE
#undef PG8_LDA
#undef PG8_LDB
#undef PG8_MMA
#undef PG8_WAIT_V
#undef PG8_WAIT_L
#undef PG8_BAR
#undef PG8_SCHED
}

__device__ __forceinline__ void remap_tile(int L, int nM, int nN, int& pm, int& pn) {
    const int nwg = nM * nN;
    int wgid = L; { const int q = nwg / NXCD, r = nwg % NXCD, xcd = wgid % NXCD, off = wgid / NXCD; wgid = (xcd < r ? xcd * (q + 1) : r * (q + 1) + (xcd - r) * q) + off; }
    const int nig = WGM * nN, gid = wgid / nig, fm = gid * WGM, gsz = (nM - fm) < WGM ? (nM - fm) : WGM;
    pm = fm + ((wgid % nig) % gsz); pn = (wgid % nig) / gsz;
}
struct SchedMain {
    const char* h; const char* wt; int nM, extra, G, c;
    __device__ __forceinline__ bool next(int i, Unit& u) const {
        const int nN = 60, nwg = nM * nN;
        const int L = i * G + c; if (L >= nwg + extra) return false;
        int pm, pn;
        if (L < nwg) {
            int wgid = L; { const int q = nwg / NXCD, r = nwg % NXCD, xcd = wgid % NXCD, off = wgid / NXCD; wgid = (xcd < r ? xcd * (q + 1) : r * (q + 1) + (xcd - r) * q) + off; }
            const int nig = WGM * nN, gid = wgid / nig, fm = gid * WGM, gsz = (nM - fm) < WGM ? (nM - fm) : WGM;
            pm = fm + ((wgid % nig) % gsz); pn = (wgid % nig) / gsz;
        } else { const int e = L - nwg; pm = 64 + (e >> 3); pn = 24 + (e & 7); }
        const bool sw = (pn >= 4 && pn < 8) || (pn >= 28 && pn < 32);
        const char* ap = h + (size_t)pm * (BM * D * 2); const char* bp = wt + (size_t)pn * (BM * D * 2);
        u.a = sw ? bp : ap; u.b = sw ? ap : bp; u.pm = pm; u.pn = pn;
        int kind;
        if (pn < 4) kind = 1; else if (pn < 8) kind = 4; else if (pn < 12) kind = 2; else if (pn < 16) kind = 0; else if (pn < 20) kind = 2;
        else if (pn < 28) kind = 0; else if (pn < 32) kind = 5; else if (pn < 36) kind = 2; else kind = 0;
        u.kind = kind; return true;
    }
};
template <int ACT> __device__ __forceinline__ void store_tile_bf16(const f32x4 (&acc)[2][2][4][2], bf16_t* base  , const size_t ld) {
#pragma unroll
    for (int ai = 0; ai < 2; ++ai)
#pragma unroll
        for (int m = 0; m < 4; ++m) { bf16_t* rowp = base + (size_t)(ai * HALF + m * 16) * ld;
#pragma unroll
            for (int bj = 0; bj < 2; ++bj) { const f32x4 v0 = acc[ai][bj][m][0], v1 = acc[ai][bj][m][1];
                u32x4 w; w.x = cvt_pk_bf16(act_f<ACT>(v0[0]), act_f<ACT>(v0[1])); w.y = cvt_pk_bf16(act_f<ACT>(v0[2]), act_f<ACT>(v0[3]));
                w.z = cvt_pk_bf16(act_f<ACT>(v1[0]), act_f<ACT>(v1[1])); w.w = cvt_pk_bf16(act_f<ACT>(v1[2]), act_f<ACT>(v1[3]));
                *(u32x4*)(rowp + bj * HALF) = w; } }
}
struct EpiMain {
    bf16_t* z; bf16_t* vgT; bf16_t* vT;
    __device__ __forceinline__ bool operator()(const f32x4 (&acc)[2][2][4][2], const Unit& u, int wr, int wc, int fr, int fq) const {
        if (u.kind < 4) {
            bf16_t* base = z + (size_t)(u.pm * BM + wr * 64 + fr) * ZLD + ((u.pn < 4 ? u.pn : u.pn < 28 ? u.pn - 4 : u.pn - 8) * BM + wc * 32 + 8 * fq);
            if (u.kind == 0) store_tile_bf16<0>(acc, base, ZLD);
            else if (u.kind == 1) store_tile_bf16<1>(acc, base, ZLD);
            else if (u.kind == 2) store_tile_bf16<2>(acc, base, ZLD);
            else store_tile_bf16<3>(acc, base, ZLD);
        } else {
            if (u.kind == 4) { bf16_t* base = vgT + (size_t)((u.pn - 4) * BM + wr * 64 + fr) * MT + (u.pm * BM + wc * 32 + 8 * fq); store_tile_bf16<1>(acc, base, MT); }
            else { bf16_t* base = vT + (size_t)((u.pn - 28) * BM + wr * 64 + fr) * MT + (u.pm * BM + wc * 32 + 8 * fq); store_tile_bf16<0>(acc, base, MT); }
        }
        return false;
    }
};

struct SchedF1 {
    const char* dft; const char* z; int nunits, G, c;
    __device__ __forceinline__ bool next(int i, Unit& u) const {
        const int L = i * G + c; if (L >= nunits) return false;
        const int mt = L & 1, g = (L >> 1) & 3, tt = L >> 3;
        u.a = dft + (size_t)mt * (256 * 256 * 2); u.b = z + ((size_t)tt * BM * ZLD + OFF_F + g * 256) * 2; u.pm = mt; u.pn = tt; u.kind = g; return true;
    }
};
struct EpiF1 {
    bf16_t* TT; bf16_t* TTc;
    __device__ __forceinline__ bool operator()(const f32x4 (&acc)[2][2][4][2], const Unit& u, int wr, int wc, int fr, int fq) const {
        const int g = u.kind, cs = u.pm, tt = u.pn;
        const int k0 = wr * 64 + fr, n0 = wc * 32 + 8 * fq;
        bf16_t* base; size_t ld;
        if (tt < 64) { const int b = tt >> 3; base = TT + ((size_t)((b * 4 + g) * 256 + k0)) * 4096 + cs * 2048 + (tt & 7) * 256 + n0; ld = 4096; }
        else { const int b = tt - 64; base = TTc + ((size_t)((b * 4 + g) * 256 + k0)) * 512 + cs * 256 + n0; ld = 512; }
        store_tile_bf16<0>(acc, base, ld);
        return false;
    }
};

struct SchedF2 {
    const char* cs; const char* tt; int nunits, ctxmode, G, c;
    __device__ __forceinline__ bool next(int i, Unit& u) const {
        const int L = i * G + c; if (L >= nunits) return false;
        if (!ctxmode) { const int bg = (L & 7) + 8 * (L >> 6), pt = (L >> 3) & 7; u.a = cs + (size_t)pt * (256 * 4096 * 2); u.b = tt + (size_t)bg * (256 * 4096 * 2); u.pm = pt; u.pn = bg; }
        else { u.a = cs; u.b = tt + (size_t)L * (256 * 512 * 2); u.pm = 0; u.pn = L; }
        u.kind = 0; return true;
    }
};
struct EpiF2 {
    const bf16_t* z; bf16_t* fb; int ctxmode; float scale;
    __device__ __forceinline__ bool operator()(const f32x4 (&acc)[2][2][4][2], const Unit& u, int wr, int wc, int fr, int fq) const {
        const int b = u.pn >> 2, g = u.pn & 3;
        const int row0 = (ctxmode ? ML + b * CTX : b * SEQ + u.pm * BM) + wr * 64 + fr, ch0 = g * 256 + wc * 32 + 8 * fq;
#pragma unroll
        for (int ai = 0; ai < 2; ++ai) {
            u32x4 gq[4][2];
#pragma unroll
            for (int m = 0; m < 4; ++m)
#pragma unroll
                for (int bj = 0; bj < 2; ++bj) gq[m][bj] = *(const u32x4*)(z + (size_t)(row0 + ai * HALF + m * 16) * ZLD + OFF_GF + ch0 + bj * HALF);
#pragma unroll
            for (int m = 0; m < 4; ++m) { const size_t row = (size_t)(row0 + ai * HALF + m * 16);
#pragma unroll
                for (int bj = 0; bj < 2; ++bj) { const f32x4 v0 = acc[ai][bj][m][0] * scale, v1 = acc[ai][bj][m][1] * scale; const u32x4 g = gq[m][bj];
                    u32x4 w; w.x = cvt_pk_bf16(v0[0] * bf_lo(g.x), v0[1] * bf_hi(g.x)); w.y = cvt_pk_bf16(v0[2] * bf_lo(g.y), v0[3] * bf_hi(g.y));
                    w.z = cvt_pk_bf16(v1[0] * bf_lo(g.z), v1[1] * bf_hi(g.z)); w.w = cvt_pk_bf16(v1[2] * bf_lo(g.w), v1[3] * bf_hi(g.w));
                    *(u32x4*)(fb + row * 1024 + ch0 + bj * HALF) = w; } }
            __builtin_amdgcn_sched_barrier(0); }
        return false;
    }
};

struct SchedMerge {
    const char* ab; const char* wp; int ntiles, G, c;
    __device__ __forceinline__ bool next(int i, Unit& u) const {
        const int t = i / 3, br = i - 3 * t; const int L = t * G + c; if (L >= ntiles) return false;
        int pm, pn; remap_tile(L, ntiles >> 3, 8, pm, pn);
        u.a = ab + (size_t)br * ((size_t)MT * 1024 * 2) + (size_t)pm * (BM * 1024 * 2); u.b = wp + (size_t)br * SZ_WPT + (size_t)pn * (BM * 1024 * 2);
        u.pm = pm; u.pn = pn; u.kind = br; return true;
    }
};
struct EpiMerge {
    const bf16_t* z; bf16_t* y;
    __device__ __forceinline__ bool operator()(f32x4 (&acc)[2][2][4][2], const Unit& u, int wr, int wc, int fr, int fq) const {
        const int br = u.kind;
        const int row0 = u.pm * BM + wr * 64 + fr, col0 = u.pn * BM + wc * 32 + 8 * fq;
#pragma unroll
        for (int ai = 0; ai < 2; ++ai) {
            u32x4 g0[4][2], g1[4][2];
#pragma unroll
            for (int m = 0; m < 4; ++m)
#pragma unroll
                for (int bj = 0; bj < 2; ++bj) { const bf16_t* gp = z + (size_t)(row0 + ai * HALF + m * 16) * ZLD + OFF_MERGE + br * D + col0 + bj * HALF;
                    g0[m][bj] = *(const u32x4*)gp; if (br < 2) g1[m][bj] = *(const u32x4*)(gp + D); }
#pragma unroll
            for (int m = 0; m < 4; ++m) { const size_t row = (size_t)(row0 + ai * HALF + m * 16);
#pragma unroll
                for (int bj = 0; bj < 2; ++bj) {
                    const u32x4 ga = g0[m][bj];
                    float f[8] = {bf_lo(ga.x), bf_hi(ga.x), bf_lo(ga.y), bf_hi(ga.y), bf_lo(ga.z), bf_hi(ga.z), bf_lo(ga.w), bf_hi(ga.w)};
#pragma unroll
                    for (int j = 0; j < 8; ++j) f[j] = sigmoid_f(f[j]);
                    if (br < 2) { const u32x4 gb = g1[m][bj];
                        const float d[8] = {bf_lo(gb.x), bf_hi(gb.x), bf_lo(gb.y), bf_hi(gb.y), bf_lo(gb.z), bf_hi(gb.z), bf_lo(gb.w), bf_hi(gb.w)};
#pragma unroll
                        for (int j = 0; j < 8; ++j) f[j] = f[j] * (1.0f + __expf(-d[j]));
                    }
#pragma unroll
                    for (int j = 0; j < 4; ++j) { acc[ai][bj][m][0][j] *= f[j]; acc[ai][bj][m][1][j] *= f[4 + j]; }
                    if (br == 2) { const f32x4 v0 = acc[ai][bj][m][0], v1 = acc[ai][bj][m][1];
                        u32x4 w; w.x = cvt_pk_bf16(v0[0], v0[1]); w.y = cvt_pk_bf16(v0[2], v0[3]); w.z = cvt_pk_bf16(v1[0], v1[1]); w.w = cvt_pk_bf16(v1[2], v1[3]);
                        *(u32x4*)(y + row * D + col0 + bj * HALF) = w; } } }
            __builtin_amdgcn_sched_barrier(0);
        }
        return br < 2;
    }
};

struct SchedOut {
    const char* y; const char* wo; int ntiles, G, c;
    __device__ __forceinline__ bool next(int i, Unit& u) const {
        const int L = i * G + c; if (L >= ntiles) return false;
        int pm, pn; remap_tile(L, ntiles >> 3, 8, pm, pn);
        u.a = y + (size_t)pm * (BM * D * 2); u.b = wo + (size_t)pn * (BM * D * 2); u.pm = pm; u.pn = pn; u.kind = 0; return true;
    }
};
struct EpiOut {
    const float* xin; const float* cin; float* xout; float* cout; const float* mod;
    __device__ __forceinline__ bool operator()(const f32x4 (&acc)[2][2][4][2], const Unit& u, int wr, int wc, int fr, int fq) const {
        const int col0 = u.pn * BM + wc * 32 + 8 * fq;
        const bool isctx = u.pm >= 64;
        const int brow = isctx ? 8 : (u.pm >> 3);
        const float* gate = mod + brow * 6144 + 2 * D + col0;
        const size_t rbase = isctx ? (size_t)(u.pm - 64) * BM : (size_t)u.pm * BM;
        const float* src = (isctx ? cin : xin) + (rbase + wr * 64 + fr) * D + col0;
        float* dst = (isctx ? cout : xout) + (rbase + wr * 64 + fr) * D + col0;
#pragma unroll
        for (int bj = 0; bj < 2; ++bj) { const f32x4 ga = *(const f32x4*)(gate + bj * HALF), gb = *(const f32x4*)(gate + bj * HALF + 4);
#pragma unroll
            for (int ai = 0; ai < 2; ++ai) {
                f32x4 x0[4], x1[4];
#pragma unroll
                for (int m = 0; m < 4; ++m) { const size_t o = (size_t)(ai * HALF + m * 16) * D + bj * HALF; x0[m] = *(const f32x4*)(src + o); x1[m] = *(const f32x4*)(src + o + 4); }
#pragma unroll
                for (int m = 0; m < 4; ++m) { const size_t o = (size_t)(ai * HALF + m * 16) * D + bj * HALF;
                    *(f32x4*)(dst + o) = x0[m] + ga * acc[ai][bj][m][0]; *(f32x4*)(dst + o + 4) = x1[m] + gb * acc[ai][bj][m][1]; }
                __builtin_amdgcn_sched_barrier(0); } }
        return false;
    }
};

__device__ __forceinline__ void transpose_tile(const float* __restrict__ src, bf16_t* __restrict__ dst, int R, int C, int tile, unsigned char* smem) {
    const int nct = C >> 8; const int rt = tile / nct, ct = tile - rt * nct; const int r0 = rt * 64, c0 = ct * 256;
    unsigned* tl = (unsigned*)smem;
    int tid_ = threadIdx.x; asm volatile("" : "+v"(tid_));
    const int tid = tid_;
    f32x4 v[8];
#pragma unroll
    for (int i = 0; i < 8; ++i) { const int idx = tid + i * 512, r = idx >> 6, c4 = (idx & 63) * 4; v[i] = *(const f32x4*)(src + (size_t)(r0 + r) * C + c0 + c4); }
#pragma unroll
    for (int i = 0; i < 8; ++i) { const int idx = tid + i * 512, r = idx >> 6, c4 = (idx & 63) * 4; tl[r * 129 + (c4 >> 1)] = cvt_pk_bf16(v[i][0], v[i][1]); tl[r * 129 + (c4 >> 1) + 1] = cvt_pk_bf16(v[i][2], v[i][3]); }
    __syncthreads();
    const bf16_t* ts = (const bf16_t*)smem;
#pragma unroll
    for (int i = 0; i < 4; ++i) { const int idx = tid + i * 512, c = idx >> 3, r8 = (idx & 7) * 8;
        unsigned short e[8];
#pragma unroll
        for (int j = 0; j < 8; ++j) e[j] = ts[(r8 + j) * 258 + c];
        u32x4 w; w.x = e[0] | ((unsigned)e[1] << 16); w.y = e[2] | ((unsigned)e[3] << 16); w.z = e[4] | ((unsigned)e[5] << 16); w.w = e[6] | ((unsigned)e[7] << 16);
        *(u32x4*)(dst + (size_t)(c0 + c) * R + r0 + r8) = w; }
    __syncthreads();
}

__device__ void phase0(const Params& p, unsigned char* smem) {
    int tid_ = threadIdx.x; asm volatile("" : "+v"(tid_));
    const int tid = tid_, bid = blockIdx.x, G = gridDim.x;
    char* ws = p.ws;
    {
        float* sc = (float*)smem;
        float* red = (float*)(smem + 9 * 2048 * 4);
        bool filled = false;
        for (int task = bid; task < 192; task += G) {
            if (!filled) { for (int i = tid; i < 9 * 2048; i += 512) { const int r = i >> 11, k = i & 2047; const float v = r < 8 ? p.c[r * D + k] : p.c_ctx[k]; sc[i] = silu_f(v); } filled = true; __syncthreads(); }
            const int l = task / 96, jb = task % 96; const int col = tid & 63, part = tid >> 6;
            const float* w = p.w_ada + (size_t)l * D * 6144 + jb * 64 + col;
            float a[9];
#pragma unroll
            for (int r = 0; r < 9; ++r) a[r] = 0.f;
            for (int kk = 0; kk < 256; ++kk) { const int k = part * 256 + kk; const float wv = w[(size_t)k * 6144];
#pragma unroll
                for (int r = 0; r < 9; ++r) a[r] += sc[r * 2048 + k] * wv; }
#pragma unroll
            for (int r = 0; r < 9; ++r) red[(part * 9 + r) * 64 + col] = a[r];
            __syncthreads();
            for (int i = tid; i < 9 * 64; i += 512) { const int r = i >> 6, cc = i & 63; float s = 0.f;
#pragma unroll
                for (int q = 0; q < 8; ++q) s += red[(q * 9 + r) * 64 + cc];
                ((float*)(ws + O_MOD))[(l * 9 + r) * 6144 + jb * 64 + cc] = s + p.b_ada[l * 6144 + jb * 64 + cc]; }
            __syncthreads();
        }
        __syncthreads();
    }
    {
        constexpr int T_IN = (D / 64) * (WIN / 256), T_P = (1024 / 64) * (D / 256), T_O = (D / 64) * (D / 256);
        constexpr int T_TOT = T_IN + 6 * T_P + 2 * T_O;
        for (int task = bid; task < T_TOT; task += G) {
            int t = task;
            if (t < T_IN) { transpose_tile(p.w_in, (bf16_t*)(ws + O_WINT), D, WIN, t, smem); continue; }
            t -= T_IN;
            if (t < 6 * T_P) { const int w = t / T_P; t -= w * T_P; const int l = w / 3, br = w % 3; const float* s = (br == 0 ? p.w_pa : br == 1 ? p.w_pf : p.w_pn) + (size_t)l * 1024 * D;
                transpose_tile(s, (bf16_t*)(ws + O_WPT + (size_t)(l * 3 + br) * SZ_WPT), 1024, D, t, smem); continue; }
            t -= 6 * T_P;
            { const int l = t / T_O; t -= l * T_O; transpose_tile(p.w_out + (size_t)l * D * D, (bf16_t*)(ws + O_WOT + l * SZ_WOT), D, D, t, smem); }
        }
    }
    {
        const size_t gt = (size_t)bid * 512 + tid, gs = (size_t)G * 512;
        bf16_t* wsb = (bf16_t*)(ws + O_WSB);
        for (size_t i = gt; i < (size_t)2 * 8 * 128 * 128 / 2; i += gs) ((unsigned*)wsb)[i] = cvt_pk_bf16(p.gws[2 * i], p.gws[2 * i + 1]);
        unsigned* dftc = (unsigned*)(ws + O_DFTC);
        for (size_t i = gt; i < (size_t)512 * 256 / 2; i += gs) { const int kp = (int)(i >> 7), c = (int)(i & 127) * 2, k = kp & 255; float v[2];
#pragma unroll
            for (int j = 0; j < 2; ++j) { const int ang = (k * (c + j)) & 255; float s, co; sincospif((float)ang * (1.0f / 128.0f), &s, &co); v[j] = kp < 256 ? co : s; }
            dftc[i] = cvt_pk_bf16(v[0], v[1]); }
        unsigned* csn = (unsigned*)(ws + O_CSN);
        for (size_t i = gt; i < (size_t)2048 * 4096 / 2; i += gs) { const int pp = (int)(i >> 11), n2 = (int)(i & 2047) * 2; float v[2];
#pragma unroll
            for (int j = 0; j < 2; ++j) { const int nn = n2 + j, n = nn & 2047; const int ang = (pp * n) & 2047; float s, co; sincospif((float)ang * (1.0f / 1024.0f), &s, &co); v[j] = nn < 2048 ? co : -s; }
            csn[i] = cvt_pk_bf16(v[0], v[1]); }
        unsigned* csc = (unsigned*)(ws + O_CSC);
        for (size_t i = gt; i < (size_t)256 * 512 / 2; i += gs) { const int pp = (int)(i >> 8), n2 = (int)(i & 255) * 2; float v[2];
#pragma unroll
            for (int j = 0; j < 2; ++j) { const int nn = n2 + j, n = nn & 255; const int ang = (pp * n) & 255; float s, co; sincospif((float)ang * (1.0f / 128.0f), &s, &co); v[j] = nn < 256 ? co : -s; }
            csc[i] = cvt_pk_bf16(v[0], v[1]); }
    }
}

__device__ void phase_norm(const Params& p, int l, const float* xin, const float* cin) {
    int tid_ = threadIdx.x; asm volatile("" : "+v"(tid_));
    const int lane = tid_ & 63, gw = blockIdx.x * 8 + (tid_ >> 6), nw = gridDim.x * 8;
    const float* mod = (const float*)(p.ws + O_MOD) + (size_t)l * 9 * 6144;
    const float* ng = p.norm_g + l * D;
    bf16_t* h = (bf16_t*)(p.ws + O_H);
    for (int row = gw; row < MT; row += nw) {
        const float* src = row < ML ? xin + (size_t)row * D : cin + (size_t)(row - ML) * D;
        const int br = row < ML ? (row >> 11) : 8;
        const float* mr = mod + br * 6144;
        f32x4 v[8]; float ss = 0.f;
#pragma unroll
        for (int i = 0; i < 8; ++i) { v[i] = *(const f32x4*)(src + i * 256 + lane * 4); ss += v[i][0] * v[i][0] + v[i][1] * v[i][1] + v[i][2] * v[i][2] + v[i][3] * v[i][3]; }
#pragma unroll
        for (int o = 32; o >= 1; o >>= 1) ss += __shfl_xor(ss, o);
        const float rstd = rsqrtf(ss * (1.0f / D) + EPS);
#pragma unroll
        for (int i = 0; i < 8; ++i) { const int d = i * 256 + lane * 4;
            const f32x4 g = *(const f32x4*)(ng + d), sh = *(const f32x4*)(mr + d), scl = *(const f32x4*)(mr + D + d);
            const f32x4 o = (v[i] * rstd * g) * (scl + 1.0f) + sh;
            u32x2 w; w.x = cvt_pk_bf16(o[0], o[1]); w.y = cvt_pk_bf16(o[2], o[3]);
            *(u32x2*)(h + (size_t)row * D + d) = w; }
    }
}

__device__ void phase_qknorm(const Params& p, int l, int last) {
    int tid_ = threadIdx.x; asm volatile("" : "+v"(tid_));
    const int lane = tid_ & 63, gw = blockIdx.x * 8 + (tid_ >> 6), nw = gridDim.x * 8;
    bf16_t* z = (bf16_t*)(p.ws + O_Z);
    const int ntask = 2 * MT;
    for (int task = gw; task < ntask; task += nw) {
        const int row = task >> 1, isk = task & 1;
        if (last && row >= ML && !isk) continue;
        bf16_t* ptr = z + (size_t)row * ZLD + (isk ? OFF_K : OFF_Q) + lane * 16;
        const float* g = (isk ? p.kg : p.qg) + l * 128 + (lane & 7) * 16;
        const u32x4 a = *(const u32x4*)ptr, b = *(const u32x4*)(ptr + 8);
        float f[16] = {bf_lo(a.x), bf_hi(a.x), bf_lo(a.y), bf_hi(a.y), bf_lo(a.z), bf_hi(a.z), bf_lo(a.w), bf_hi(a.w),
                       bf_lo(b.x), bf_hi(b.x), bf_lo(b.y), bf_hi(b.y), bf_lo(b.z), bf_hi(b.z), bf_lo(b.w), bf_hi(b.w)};
        float ss = 0.f;
#pragma unroll
        for (int j = 0; j < 16; ++j) ss += f[j] * f[j];
        ss += __shfl_xor(ss, 1); ss += __shfl_xor(ss, 2); ss += __shfl_xor(ss, 4);
        float rs = rsqrtf(ss * (1.0f / 128.0f) + EPS);
        if (!isk) rs *= 0.08838834764831845f;
#pragma unroll
        for (int j = 0; j < 16; ++j) f[j] = f[j] * rs * g[j];
        u32x4 oa, ob;
        oa.x = cvt_pk_bf16(f[0], f[1]); oa.y = cvt_pk_bf16(f[2], f[3]); oa.z = cvt_pk_bf16(f[4], f[5]); oa.w = cvt_pk_bf16(f[6], f[7]);
        ob.x = cvt_pk_bf16(f[8], f[9]); ob.y = cvt_pk_bf16(f[10], f[11]); ob.z = cvt_pk_bf16(f[12], f[13]); ob.w = cvt_pk_bf16(f[14], f[15]);
        *(u32x4*)ptr = oa; *(u32x4*)(ptr + 8) = ob;
    }
}
__device__ void phase_lnstats(const Params& p, int ntok, unsigned char* smem) {
    int tid_ = threadIdx.x; asm volatile("" : "+v"(tid_));
    const int tid = tid_, tk = tid & 63, part = tid >> 6;
    const bf16_t* vgT = (const bf16_t*)(p.ws + O_VGT);
    float* stats = (float*)(p.ws + O_STATS);
    float* red = (float*)smem;
    for (int task = blockIdx.x; task < ntok / 64; task += gridDim.x) {
        const int tok = task * 64 + tk; float s = 0.f, q = 0.f;
        const bf16_t* src = vgT + (size_t)(part * 128) * MT + tok;
#pragma unroll 8
        for (int i = 0; i < 128; ++i) { const float v = bf2f(src[(size_t)i * MT]); s += v; q += v * v; }
        red[(part * 64 + tk) * 2] = s; red[(part * 64 + tk) * 2 + 1] = q;
        __syncthreads();
        if (part == 0) { float S = 0.f, Q = 0.f;
#pragma unroll
            for (int j = 0; j < 8; ++j) { S += red[(j * 64 + tk) * 2]; Q += red[(j * 64 + tk) * 2 + 1]; }
            const float mu = S * (1.0f / 1024.0f); const float var = fmaxf(Q * (1.0f / 1024.0f) - mu * mu, 0.f);
            stats[2 * tok] = mu; stats[2 * tok + 1] = rsqrtf(var + EPS); }
        __syncthreads();
    }
}

__device__ __forceinline__ void gmlp_task(const Params& p, int l, int task, int lane) {
    const int fr = lane & 15, fq = lane >> 4;
    const int cblk = task & 7, g = (task >> 3) & 7, ck = task >> 6;
    const int row0 = ck * 128;
    const bf16_t* vgT = (const bf16_t*)(p.ws + O_VGT);
    const float* stats = (const float*)(p.ws + O_STATS);
    const bf16_t* wsb = (const bf16_t*)(p.ws + O_WSB) + (size_t)(l * 8 + g) * 128 * 128;
    const bf16_t* z = (const bf16_t*)(p.ws + O_Z);
    bf16_t* ab = (bf16_t*)(p.ws + O_AB);
    const int ch = g * 128 + cblk * 16 + fr;
    const float lg = p.ln_g[l * 1024 + ch], lb = p.ln_b[l * 1024 + ch];
    bf16x8 af[4];
#pragma unroll
    for (int ks = 0; ks < 4; ++ks) { const int q0 = ks * 32 + fq * 8;
        const u32x4 raw = *(const u32x4*)(vgT + (size_t)ch * MT + row0 + q0);
        const float* st = stats + (size_t)(row0 + q0) * 2;
        const f32x4 s0 = *(const f32x4*)st, s1 = *(const f32x4*)(st + 4), s2 = *(const f32x4*)(st + 8), s3 = *(const f32x4*)(st + 12);
        const float e0 = (bf_lo(raw.x) - s0[0]) * s0[1] * lg + lb, e1 = (bf_hi(raw.x) - s0[2]) * s0[3] * lg + lb;
        const float e2 = (bf_lo(raw.y) - s1[0]) * s1[1] * lg + lb, e3 = (bf_hi(raw.y) - s1[2]) * s1[3] * lg + lb;
        const float e4 = (bf_lo(raw.z) - s2[0]) * s2[1] * lg + lb, e5 = (bf_hi(raw.z) - s2[2]) * s2[3] * lg + lb;
        const float e6 = (bf_lo(raw.w) - s3[0]) * s3[1] * lg + lb, e7 = (bf_hi(raw.w) - s3[2]) * s3[3] * lg + lb;
        u32x4 w; w.x = cvt_pk_bf16(e0, e1); w.y = cvt_pk_bf16(e2, e3); w.z = cvt_pk_bf16(e4, e5); w.w = cvt_pk_bf16(e6, e7);
        af[ks] = __builtin_bit_cast(bf16x8, w); }
    const float* bs = p.gbs + (l * 8 + g) * 128;
#pragma unroll 2
    for (int pb = 0; pb < 8; ++pb) {
        f32x4 acc = {0.f, 0.f, 0.f, 0.f};
#pragma unroll
        for (int ks = 0; ks < 4; ++ks) { const bf16x8 bfr = *(const bf16x8*)(wsb + (size_t)(pb * 16 + fr) * 128 + ks * 32 + fq * 8);
            acc = __builtin_amdgcn_mfma_f32_16x16x32_bf16(af[ks], bfr, acc, 0, 0, 0); }
        const int row = row0 + pb * 16 + fr, cc = g * 128 + cblk * 16 + 4 * fq;
        const float bsv = bs[pb * 16 + fr];
        const u32x2 uu = *(const u32x2*)(z + (size_t)row * ZLD + OFF_U + cc), gg = *(const u32x2*)(z + (size_t)row * ZLD + OFF_GA + cc);
        u32x2 w; w.x = cvt_pk_bf16(bf_lo(uu.x) * (acc[0] + bsv) * bf_lo(gg.x), bf_hi(uu.x) * (acc[1] + bsv) * bf_hi(gg.x));
        w.y = cvt_pk_bf16(bf_lo(uu.y) * (acc[2] + bsv) * bf_lo(gg.y), bf_hi(uu.y) * (acc[3] + bsv) * bf_hi(gg.y));
        *(u32x2*)(ab + (size_t)row * 1024 + cc) = w;
    }
}

__device__ __forceinline__ void attn_task(const Params& p, int l, int task, int ctxq, int lane) {
    const int fr = lane & 15, fq = lane >> 4;
    const bf16_t* z = (const bf16_t*)(p.ws + O_Z);
    const bf16_t* vT = (const bf16_t*)(p.ws + O_VT);
    bf16_t* nb = (bf16_t*)(p.ws + O_NB);
    int b, h, r = 0, j = 0, qrow0;
    if (!ctxq) { j = task & 3; r = (task >> 2) & 31; h = (task >> 7) & 7; b = task >> 10; qrow0 = b * SEQ + r * 64 + j * 16; }
    else { const int qb = task & 15; h = (task >> 4) & 7; b = task >> 7; qrow0 = ML + b * CTX + qb * 16; }
    bf16x8 qf[4];
#pragma unroll
    for (int ks = 0; ks < 4; ++ks) qf[ks] = *(const bf16x8*)(z + (size_t)(qrow0 + fr) * ZLD + OFF_Q + h * 128 + ks * 32 + fq * 8);
    f32x4 o[8];
#pragma unroll
    for (int i = 0; i < 8; ++i) o[i] = (f32x4){0.f, 0.f, 0.f, 0.f};
    float mrun = -INFINITY, lrun = 0.f;
    const int rs = min(max(r - 4, 0), 24), band0 = min(max(j * 16 - 8, 0), 32);
    const int cq = j * 16 + fr, cstart = min(max(cq - 8, 0), 48);
    const float* rpb = p.rpb + (size_t)(l * 8 + h) * 15 * 31;
    const int nloc = ctxq ? 0 : 8;
    const int nsteps = nloc + 8;
    auto krow_of = [&](int step) { return (step < nloc) ? (b * SEQ + (rs + step) * 64 + band0) : (ML + b * CTX + (step - nloc) * 32); };
    const int kperm = 8 * (fr >> 2) + (fr & 3);
    bf16x8 kcur[2][4], knxt[2][4];
    { const int kr0 = krow_of(0);
#pragma unroll
      for (int kb = 0; kb < 2; ++kb)
#pragma unroll
        for (int ks = 0; ks < 4; ++ks) kcur[kb][ks] = *(const bf16x8*)(z + (size_t)(kr0 + kperm + 4 * kb) * ZLD + OFF_K + h * 128 + fq * 8 + ks * 32); }
    for (int step = 0; step < nsteps; ++step) {
        const bool loc = step < nloc;
        const int kr = rs + step;
        const int krow0 = krow_of(step);
        const bf16_t* vp = vT + (size_t)(h * 128 + fr) * MT + krow0 + 8 * fq;
        bf16x8 vv[8];
#pragma unroll
        for (int db = 0; db < 8; ++db) vv[db] = *(const bf16x8*)(vp + (size_t)(db * 16) * MT);
        { const int krn = krow_of(step + 1 < nsteps ? step + 1 : step);
#pragma unroll
          for (int kb = 0; kb < 2; ++kb)
#pragma unroll
            for (int ks = 0; ks < 4; ++ks) knxt[kb][ks] = *(const bf16x8*)(z + (size_t)(krn + kperm + 4 * kb) * ZLD + OFF_K + h * 128 + fq * 8 + ks * 32); }
        f32x4 st[2];
#pragma unroll
        for (int kb = 0; kb < 2; ++kb) { f32x4 a = {0.f, 0.f, 0.f, 0.f};
#pragma unroll
            for (int ks = 0; ks < 4; ++ks) a = __builtin_amdgcn_mfma_f32_16x16x32_bf16(kcur[kb][ks], qf[ks], a, 0, 0, 0);
            st[kb] = a; }
        if (loc) { const int dr = kr - r;
#pragma unroll
            for (int kb = 0; kb < 2; ++kb)
#pragma unroll
                for (int jj = 0; jj < 4; ++jj) { const int ckc = band0 + 8 * fq + 4 * kb + jj; const bool valid = (ckc >= cstart) && (ckc < cstart + 16);
                    const int dc = valid ? (ckc - cq) : 0; const float bias = rpb[(dr + 7) * 31 + dc + 15];
                    st[kb][jj] = valid ? st[kb][jj] + bias : -INFINITY; } }
        float mx = fmaxf(fmaxf(fmaxf(st[0][0], st[0][1]), fmaxf(st[0][2], st[0][3])), fmaxf(fmaxf(st[1][0], st[1][1]), fmaxf(st[1][2], st[1][3])));
        mx = fmaxf(mx, __shfl_xor(mx, 16)); mx = fmaxf(mx, __shfl_xor(mx, 32));
        const float mnew = fmaxf(mrun, mx);
        const float alpha = __expf(mrun - mnew);
        mrun = mnew;
        float pv[8]; float psum = 0.f;
#pragma unroll
        for (int kb = 0; kb < 2; ++kb)
#pragma unroll
            for (int jj = 0; jj < 4; ++jj) { const float e = __expf(st[kb][jj] - mnew); pv[kb * 4 + jj] = e; psum += e; }
        lrun = lrun * alpha + psum;
        u32x4 pw; pw.x = cvt_pk_bf16(pv[0], pv[1]); pw.y = cvt_pk_bf16(pv[2], pv[3]); pw.z = cvt_pk_bf16(pv[4], pv[5]); pw.w = cvt_pk_bf16(pv[6], pv[7]);
        const bf16x8 pf = __builtin_bit_cast(bf16x8, pw);
#pragma unroll
        for (int db = 0; db < 8; ++db) { o[db] = o[db] * alpha;
            o[db] = __builtin_amdgcn_mfma_f32_16x16x32_bf16(vv[db], pf, o[db], 0, 0, 0); }
#pragma unroll
        for (int kb = 0; kb < 2; ++kb)
#pragma unroll
            for (int ks = 0; ks < 4; ++ks) kcur[kb][ks] = knxt[kb][ks];
    }
    lrun += __shfl_xor(lrun, 16); lrun += __shfl_xor(lrun, 32);
    const float inv = 1.0f / lrun;
    const size_t row = (size_t)(qrow0 + fr);
#pragma unroll
    for (int db = 0; db < 8; ++db) { const int cc = h * 128 + db * 16 + 4 * fq;
        const u32x2 gg = *(const u32x2*)(z + row * ZLD + OFF_GN + cc);
        u32x2 w; w.x = cvt_pk_bf16(o[db][0] * inv * bf_lo(gg.x), o[db][1] * inv * bf_hi(gg.x)); w.y = cvt_pk_bf16(o[db][2] * inv * bf_lo(gg.y), o[db][3] * inv * bf_hi(gg.y));
        *(u32x2*)(nb + row * 1024 + cc) = w; }
}

#ifndef PM
#define PM 0xFFFF
#endif
#define XB_CNT(j) (64 * (j))
#define XB_SUB(j) (1024 + 64 * (j))
#define XB_TOP 2048
#define XB_ALL 2112
#define XB_BYTES 16384
__device__ __forceinline__ unsigned xb_ld(unsigned* p) { return __hip_atomic_load(p, __ATOMIC_RELAXED, __HIP_MEMORY_SCOPE_AGENT); }
__device__ __forceinline__ unsigned xb_add(unsigned* p, unsigned v) { return __hip_atomic_fetch_add(p, v, __ATOMIC_RELAXED, __HIP_MEMORY_SCOPE_AGENT); }
__device__ __forceinline__ void grid_barrier(unsigned* bar, unsigned epoch, volatile unsigned* bs) {
    int t_ = threadIdx.x; asm volatile("" : "+v"(t_));
    const int lane = t_ & 63, wave = __builtin_amdgcn_readfirstlane(t_ >> 6);
    asm volatile("s_waitcnt vmcnt(0)" ::: "memory");
    if (lane == 0) atomicAdd((unsigned*)&bs[0], 1u);
    if (wave == 0) {
        bool lastx = false;
        if (lane == 0) { while (bs[0] < 8u * epoch) __builtin_amdgcn_s_sleep(1);
            const unsigned old = xb_add(&bar[XB_SUB(bs[4])], 1u); lastx = (old + 1u == bs[2] * epoch); }
        lastx = __builtin_amdgcn_readfirstlane(lastx ? 1 : 0) != 0;
        if (lastx) {
            __builtin_amdgcn_fence(__ATOMIC_RELEASE, "agent");
            asm volatile("s_waitcnt vmcnt(0)" ::: "memory");
            if (lane == 0) xb_add(&bar[XB_TOP], 1u);
        }
        if (lane == 0) { const unsigned need = bs[3] * epoch; while (xb_ld(&bar[XB_TOP]) < need) __builtin_amdgcn_s_sleep(8); }
        __builtin_amdgcn_fence(__ATOMIC_ACQUIRE, "agent");
        asm volatile("s_waitcnt vmcnt(0)" ::: "memory");
        if (lane == 0) bs[1] = epoch;
    }
    while (bs[1] < epoch) __builtin_amdgcn_s_sleep(4);
    asm volatile("" ::: "memory");
}
__device__ __forceinline__ void grid_barrier_setup(unsigned* bar, volatile unsigned* bs) {
    if (threadIdx.x == 0) {
        const unsigned x = (unsigned)__builtin_amdgcn_s_getreg((3 << 11) | 20) & 0xFu;
        bs[0] = 0u; bs[1] = 0u; bs[4] = x;
        xb_add(&bar[XB_CNT(x)], 1u);
        xb_add(&bar[XB_ALL], 1u);
        while (xb_ld(&bar[XB_ALL]) < gridDim.x) __builtin_amdgcn_s_sleep(8);
        unsigned nx = 0u; for (int j = 0; j < 16; ++j) nx += (xb_ld(&bar[XB_CNT(j)]) != 0u) ? 1u : 0u;
        bs[2] = xb_ld(&bar[XB_CNT(x)]); bs[3] = nx;
    }
    __syncthreads();
}
#define GSYNCN(e) do { grid_barrier((unsigned*)(p.ws + WS_TOTAL), (unsigned)(e), blk_sync); } while (0)
__device__ __forceinline__ void gmlp_task2(const Params& p, int l, int task, int lane) {
    const int fr = lane & 15, fq = lane >> 4;
    const int cb = task & 3, g = (task >> 2) & 7, ck = task >> 5;
    const int row0 = ck * 128;
    const bf16_t* vgT = (const bf16_t*)(p.ws + O_VGT);
    const float* stats = (const float*)(p.ws + O_STATS);
    const bf16_t* wsb = (const bf16_t*)(p.ws + O_WSB) + (size_t)(l * 8 + g) * 128 * 128;
    const bf16_t* z = (const bf16_t*)(p.ws + O_Z);
    bf16_t* ab = (bf16_t*)(p.ws + O_AB);
    const int chb = g * 128 + cb * 32 + 8 * (fr >> 2) + (fr & 3);
    bf16x8 af[2][4];
#pragma unroll
    for (int ks = 0; ks < 4; ++ks) { const int q0 = ks * 32 + fq * 8;
        const float* st = stats + (size_t)(row0 + q0) * 2;
        const f32x4 s0 = *(const f32x4*)st, s1 = *(const f32x4*)(st + 4), s2 = *(const f32x4*)(st + 8), s3 = *(const f32x4*)(st + 12);
#pragma unroll
        for (int kb = 0; kb < 2; ++kb) { const int ch = chb + 4 * kb;
            const float lg = p.ln_g[l * 1024 + ch], lb = p.ln_b[l * 1024 + ch];
            const u32x4 raw = *(const u32x4*)(vgT + (size_t)ch * MT + row0 + q0);
            const float e0 = (bf_lo(raw.x) - s0[0]) * s0[1] * lg + lb, e1 = (bf_hi(raw.x) - s0[2]) * s0[3] * lg + lb;
            const float e2 = (bf_lo(raw.y) - s1[0]) * s1[1] * lg + lb, e3 = (bf_hi(raw.y) - s1[2]) * s1[3] * lg + lb;
            const float e4 = (bf_lo(raw.z) - s2[0]) * s2[1] * lg + lb, e5 = (bf_hi(raw.z) - s2[2]) * s2[3] * lg + lb;
            const float e6 = (bf_lo(raw.w) - s3[0]) * s3[1] * lg + lb, e7 = (bf_hi(raw.w) - s3[2]) * s3[3] * lg + lb;
            u32x4 w; w.x = cvt_pk_bf16(e0, e1); w.y = cvt_pk_bf16(e2, e3); w.z = cvt_pk_bf16(e4, e5); w.w = cvt_pk_bf16(e6, e7);
            af[kb][ks] = __builtin_bit_cast(bf16x8, w); } }
    const float* bs = p.gbs + (l * 8 + g) * 128;
#pragma unroll 2
    for (int pb = 0; pb < 8; ++pb) {
        f32x4 acc0 = {0.f, 0.f, 0.f, 0.f}, acc1 = {0.f, 0.f, 0.f, 0.f};
#pragma unroll
        for (int ks = 0; ks < 4; ++ks) { const bf16x8 bfr = *(const bf16x8*)(wsb + (size_t)(pb * 16 + fr) * 128 + ks * 32 + fq * 8);
            acc0 = __builtin_amdgcn_mfma_f32_16x16x32_bf16(af[0][ks], bfr, acc0, 0, 0, 0);
            acc1 = __builtin_amdgcn_mfma_f32_16x16x32_bf16(af[1][ks], bfr, acc1, 0, 0, 0); }
        const int row = row0 + pb * 16 + fr, cc = g * 128 + cb * 32 + 8 * fq;
        const float bsv = bs[pb * 16 + fr];
        const u32x4 uu = *(const u32x4*)(z + (size_t)row * ZLD + OFF_U + cc), gg = *(const u32x4*)(z + (size_t)row * ZLD + OFF_GA + cc);
        u32x4 w;
        w.x = cvt_pk_bf16(bf_lo(uu.x) * (acc0[0] + bsv) * bf_lo(gg.x), bf_hi(uu.x) * (acc0[1] + bsv) * bf_hi(gg.x));
        w.y = cvt_pk_bf16(bf_lo(uu.y) * (acc0[2] + bsv) * bf_lo(gg.y), bf_hi(uu.y) * (acc0[3] + bsv) * bf_hi(gg.y));
        w.z = cvt_pk_bf16(bf_lo(uu.z) * (acc1[0] + bsv) * bf_lo(gg.z), bf_hi(uu.z) * (acc1[1] + bsv) * bf_hi(gg.z));
        w.w = cvt_pk_bf16(bf_lo(uu.w) * (acc1[2] + bsv) * bf_lo(gg.w), bf_hi(uu.w) * (acc1[3] + bsv) * bf_hi(gg.w));
        *(u32x4*)(ab + (size_t)row * 1024 + cc) = w;
    }
}

__device__ __forceinline__ void attn_task2(const Params& p, int l, int task, int lane) {
    const int fr = lane & 15, fq = lane >> 4;
    const bf16_t* z = (const bf16_t*)(p.ws + O_Z);
    const bf16_t* vT = (const bf16_t*)(p.ws + O_VT);
    bf16_t* nb = (bf16_t*)(p.ws + O_NB);
    const int j = task & 3, rp = (task >> 2) & 15, h = (task >> 6) & 7, b = task >> 9;
    const int r0 = 2 * rp;
    const int qrow0 = b * SEQ + r0 * 64 + j * 16;
    bf16x8 qf[2][4];
#pragma unroll
    for (int qi = 0; qi < 2; ++qi)
#pragma unroll
        for (int ks = 0; ks < 4; ++ks) qf[qi][ks] = *(const bf16x8*)(z + (size_t)(qrow0 + qi * 64 + fr) * ZLD + OFF_Q + h * 128 + ks * 32 + fq * 8);
    f32x4 o[2][8];
#pragma unroll
    for (int qi = 0; qi < 2; ++qi)
#pragma unroll
        for (int i = 0; i < 8; ++i) o[qi][i] = (f32x4){0.f, 0.f, 0.f, 0.f};
    float mrun[2] = {-INFINITY, -INFINITY}, lrun[2] = {0.f, 0.f};
    const int rsA = min(max(r0 - 4, 0), 24), rsB = min(max(r0 - 3, 0), 24);
    const int nloc = rsB + 8 - rsA;
    const int band0 = min(max(j * 16 - 8, 0), 32);
    const int cq = j * 16 + fr, cstart = min(max(cq - 8, 0), 48);
    const float* rpb = p.rpb + (size_t)(l * 8 + h) * 15 * 31;
    const int nsteps = nloc + 8;
    const int kperm = 8 * (fr >> 2) + (fr & 3);
    auto krow_of = [&](int step) { return (step < nloc) ? (b * SEQ + (rsA + step) * 64 + band0) : (ML + b * CTX + (step - nloc) * 32); };
    for (int step = 0; step < nsteps; ++step) {
        const bool loc = step < nloc;
        const int kr = rsA + step;
        const int krow0 = krow_of(step);
        const bf16_t* vp = vT + (size_t)(h * 128 + fr) * MT + krow0 + 8 * fq;
        bf16x8 vv[8];
#pragma unroll
        for (int db = 0; db < 8; ++db) vv[db] = *(const bf16x8*)(vp + (size_t)(db * 16) * MT);
        bf16x8 kcur[2][4];
#pragma unroll
        for (int kb = 0; kb < 2; ++kb)
#pragma unroll
            for (int ks = 0; ks < 4; ++ks) kcur[kb][ks] = *(const bf16x8*)(z + (size_t)(krow0 + kperm + 4 * kb) * ZLD + OFF_K + h * 128 + fq * 8 + ks * 32);
#pragma unroll
        for (int qi = 0; qi < 2; ++qi) {
            const int rsq = qi ? rsB : rsA;
            const bool active = !loc || (kr >= rsq && kr < rsq + 8);
            if (active) {
                f32x4 st[2];
#pragma unroll
                for (int kb = 0; kb < 2; ++kb) { f32x4 a = {0.f, 0.f, 0.f, 0.f};
#pragma unroll
                    for (int ks = 0; ks < 4; ++ks) a = __builtin_amdgcn_mfma_f32_16x16x32_bf16(kcur[kb][ks], qf[qi][ks], a, 0, 0, 0);
                    st[kb] = a; }
                if (loc) { const int dr = kr - (r0 + qi);
#pragma unroll
                    for (int kb = 0; kb < 2; ++kb)
#pragma unroll
                        for (int jj = 0; jj < 4; ++jj) { const int ckc = band0 + 8 * fq + 4 * kb + jj; const bool valid = (ckc >= cstart) && (ckc < cstart + 16);
                            const int dc = valid ? (ckc - cq) : 0; const float bias = rpb[(dr + 7) * 31 + dc + 15];
                            st[kb][jj] = valid ? st[kb][jj] + bias : -INFINITY; } }
                float mx = fmaxf(fmaxf(fmaxf(st[0][0], st[0][1]), fmaxf(st[0][2], st[0][3])), fmaxf(fmaxf(st[1][0], st[1][1]), fmaxf(st[1][2], st[1][3])));
                mx = fmaxf(mx, __shfl_xor(mx, 16)); mx = fmaxf(mx, __shfl_xor(mx, 32));
                const float mnew = fmaxf(mrun[qi], mx);
                const float alpha = __expf(mrun[qi] - mnew);
                mrun[qi] = mnew;
                float pv[8]; float psum = 0.f;
#pragma unroll
                for (int kb = 0; kb < 2; ++kb)
#pragma unroll
                    for (int jj = 0; jj < 4; ++jj) { const float e = __expf(st[kb][jj] - mnew); pv[kb * 4 + jj] = e; psum += e; }
                lrun[qi] = lrun[qi] * alpha + psum;
                u32x4 pw; pw.x = cvt_pk_bf16(pv[0], pv[1]); pw.y = cvt_pk_bf16(pv[2], pv[3]); pw.z = cvt_pk_bf16(pv[4], pv[5]); pw.w = cvt_pk_bf16(pv[6], pv[7]);
                const bf16x8 pf = __builtin_bit_cast(bf16x8, pw);
#pragma unroll
                for (int db = 0; db < 8; ++db) { o[qi][db] = o[qi][db] * alpha;
                    o[qi][db] = __builtin_amdgcn_mfma_f32_16x16x32_bf16(vv[db], pf, o[qi][db], 0, 0, 0); }
            }
        }
    }
#pragma unroll
    for (int qi = 0; qi < 2; ++qi) {
        float lr = lrun[qi]; lr += __shfl_xor(lr, 16); lr += __shfl_xor(lr, 32);
        const float inv = 1.0f / lr;
        const size_t row = (size_t)(qrow0 + qi * 64 + fr);
#pragma unroll
        for (int db = 0; db < 8; ++db) { const int cc = h * 128 + db * 16 + 4 * fq;
            const u32x2 gg = *(const u32x2*)(z + row * ZLD + OFF_GN + cc);
            u32x2 w; w.x = cvt_pk_bf16(o[qi][db][0] * inv * bf_lo(gg.x), o[qi][db][1] * inv * bf_hi(gg.x)); w.y = cvt_pk_bf16(o[qi][db][2] * inv * bf_lo(gg.y), o[qi][db][3] * inv * bf_hi(gg.y));
            *(u32x2*)(nb + row * 1024 + cc) = w; }
    }
}

template <int PH> __device__ __forceinline__ void do_phase(const Params& p, const int l, unsigned char* smem) {
    LAS unsigned char* lds = (LAS unsigned char*)smem;
    const int bid = blockIdx.x, G = gridDim.x;
    char* ws = p.ws;
    const int last = (l == 1);
    const float* xin = last ? (const float*)p.out : p.x;
    const float* cin = last ? (const float*)(ws + O_C1) : p.ctx;
    float* xout = p.out;
    float* cout = (float*)(ws + O_C1);
    if (PH == 0) { phase0(p, smem); }
    if (PH == 1) {
        phase_norm(p, l, xin, cin);
        if (last) { __syncthreads(); for (int t = bid; t < (D / 64) * (WIN / 256); t += G) transpose_tile(p.w_in + (size_t)D * WIN, (bf16_t*)(ws + O_WINT), D, WIN, t, smem); }
    }
    if (PH == 2) {
        SchedMain S; S.h = ws + O_H; S.wt = ws + O_WINT; S.nM = last ? 64 : 72; S.extra = last ? 64 : 0; S.G = G; S.c = bid;
        EpiMain E; E.z = (bf16_t*)(ws + O_Z); E.vgT = (bf16_t*)(ws + O_VGT); E.vT = (bf16_t*)(ws + O_VT);
        gemm_phase(lds, D, D, D, S, E);
    }
    if (PH == 3) {
        { SchedF1 S; S.dft = ws + O_DFTC; S.z = ws + O_Z; S.nunits = (last ? 64 : 72) * 8; S.G = G; S.c = bid;
          EpiF1 E; E.TT = (bf16_t*)(ws + O_TT); E.TTc = (bf16_t*)(ws + O_TTC);
          gemm_phase(lds, 256, ZLD, 256, S, E); }
        phase_qknorm(p, l, last);
        __syncthreads();
        phase_lnstats(p, last ? ML : MT, smem);
    }
    if (PH == 4) {
        { SchedF2 S; S.cs = ws + O_CSN; S.tt = ws + O_TT; S.nunits = 256; S.ctxmode = 0; S.G = G; S.c = bid;
          EpiF2 E; E.z = (const bf16_t*)(ws + O_Z); E.fb = (bf16_t*)(ws + O_FB); E.ctxmode = 0; E.scale = 0.001381067932f;
          gemm_phase(lds, 4096, 4096, 4096, S, E); }
        if (!last) {
            SchedF2 S; S.cs = ws + O_CSC; S.tt = ws + O_TTC; S.nunits = 32; S.ctxmode = 1; S.G = G; S.c = (bid + 128) % G;
            EpiF2 E; E.z = (const bf16_t*)(ws + O_Z); E.fb = (bf16_t*)(ws + O_FB); E.ctxmode = 1; E.scale = 0.00390625f;
            gemm_phase(lds, 512, 512, 512, S, E);
        }
        {
            const int ngm = (last ? ML : MT) / 128 * 32;
            int tid_ = threadIdx.x; asm volatile("" : "+v"(tid_));
            const int lane = tid_ & 63, gw = bid * 8 + __builtin_amdgcn_readfirstlane(tid_ >> 6), nw = G * 8;
            for (int t = gw; t < ngm; t += nw) gmlp_task2(p, l, t, lane);
            for (int t = gw; t < 4096; t += nw) attn_task2(p, l, t, lane);
            if (!last) for (int t = gw; t < 1024; t += nw) attn_task(p, l, t, 1, lane);
        }
    }
    if (PH == 5) {
        SchedMerge S; S.ab = ws + O_AB; S.wp = ws + O_WPT + (size_t)l * 3 * SZ_WPT; S.ntiles = (last ? 64 : 72) * 8; S.G = G; S.c = bid;
        EpiMerge E; E.z = (const bf16_t*)(ws + O_Z); E.y = (bf16_t*)(ws + O_Y);
        gemm_phase(lds, 1024, 1024, 1024, S, E);
    }
    if (PH == 6) {
        SchedOut S; S.y = ws + O_Y; S.wo = ws + O_WOT + (size_t)l * SZ_WOT; S.ntiles = (last ? 64 : 72) * 8; S.G = G; S.c = bid;
        EpiOut E; E.xin = xin; E.cin = cin; E.xout = xout; E.cout = cout; E.mod = (const float*)(ws + O_MOD) + (size_t)l * 9 * 6144;
        gemm_phase(lds, D, D, D, S, E);
    }
}

#ifndef MULTI_LAUNCH
#define MULTI_LAUNCH 0
#endif
#if MULTI_LAUNCH
template <int PH> __global__ void __launch_bounds__(512, 2) k_phase(Params p, int l) {
    __shared__ __attribute__((aligned(16))) unsigned char smem[STAGE_BYTES];
    do_phase<PH>(p, l, smem);
}
#else
__global__ void __launch_bounds__(512, 2) fwd_megakernel(Params p) {
    __shared__ __attribute__((aligned(1024))) unsigned char smem[STAGE_BYTES + 32];
    unsigned* blk_sync = (unsigned*)(smem + STAGE_BYTES);
    cg::grid_group grid = cg::this_grid();
    grid_barrier_setup((unsigned*)(p.ws + WS_TOTAL), blk_sync);
    do_phase<0>(p, 0, smem);
    GSYNCN(1);
#pragma unroll 1
    for (int l = 0; l < 2; ++l) {
        do_phase<1>(p, l, smem); GSYNCN(1 + 6 * l + 1);
        do_phase<2>(p, l, smem); GSYNCN(1 + 6 * l + 2);
        do_phase<3>(p, l, smem); GSYNCN(1 + 6 * l + 3);
        do_phase<4>(p, l, smem); GSYNCN(1 + 6 * l + 4);
        do_phase<5>(p, l, smem); GSYNCN(1 + 6 * l + 5);
        do_phase<6>(p, l, smem); if (l == 0) GSYNCN(1 + 6 * l + 6);
    }
    grid.sync();
}
#endif

extern "C" void kernel_launch(void* const* d_in, const int* in_sizes, int n_in, void* d_out, int out_size, void* d_ws, size_t ws_size, hipStream_t stream) {
    static int grid_blocks = 0;
    if (!grid_blocks) {
        int dev = 0, cus = 0, per_cu = 0;
        hipGetDevice(&dev);
        hipDeviceGetAttribute(&cus, hipDeviceAttributeMultiprocessorCount, dev);
        grid_blocks = cus;
    }
    if (ws_size < WS_TOTAL + XB_BYTES) { fprintf(stderr, "workspace too small: %zu < %zu\n", ws_size, (size_t)WS_TOTAL); return; }
    Params p{};
    const float* const* in = (const float* const*)d_in;
    p.x = in[0]; p.c = in[1]; p.ctx = in[2]; p.c_ctx = in[3]; p.norm_g = in[4]; p.w_ada = in[5]; p.b_ada = in[6]; p.w_in = in[7]; p.ln_g = in[8]; p.ln_b = in[9];
    p.gws = in[10]; p.gbs = in[11]; p.qg = in[12]; p.kg = in[13]; p.rpb = in[14]; p.w_pa = in[15]; p.w_pf = in[16]; p.w_pn = in[17]; p.w_out = in[18];
    p.out = (float*)d_out; p.ws = (char*)d_ws;
#if MULTI_LAUNCH
    const dim3 g(256), b(512);
    k_phase<0><<<g, b, 0, stream>>>(p, 0);
    for (int l = 0; l < 2; ++l) {
        k_phase<1><<<g, b, 0, stream>>>(p, l); k_phase<2><<<g, b, 0, stream>>>(p, l); k_phase<3><<<g, b, 0, stream>>>(p, l);
        k_phase<4><<<g, b, 0, stream>>>(p, l); k_phase<5><<<g, b, 0, stream>>>(p, l); k_phase<6><<<g, b, 0, stream>>>(p, l);
    }
#else
    hipMemsetAsync((char*)d_ws + WS_TOTAL, 0, XB_BYTES, stream);
    void* args[] = {&p};
    hipError_t e = hipLaunchCooperativeKernel((void*)fwd_megakernel, dim3(grid_blocks), dim3(512), args, 0, stream);
    if (e != hipSuccess) fprintf(stderr, "cooperative launch failed: %s (grid %d)\n", hipGetErrorString(e), grid_blocks);
#endif
}
```

```cpp
#include <hip/hip_runtime.h>
#include <hip/hip_cooperative_groups.h>
#include <cstdio>
namespace cg = cooperative_groups;

#define LAS __attribute__((address_space(3)))
typedef unsigned short bf16_t;
typedef short bf16x8 __attribute__((ext_vector_type(8)));
typedef float f32x4 __attribute__((ext_vector_type(4)));
typedef float f32x2 __attribute__((ext_vector_type(2)));
typedef unsigned u32x4 __attribute__((ext_vector_type(4)));
typedef unsigned u32x2 __attribute__((ext_vector_type(2)));

constexpr int D = 2048, NB = 8, SEQ = 2048, CTX = 256, WIN = 15360;
constexpr int ML = NB * SEQ, MC = NB * CTX, MT = ML + MC;
constexpr int ZLD = 13312, OFF_U = 0, OFF_GA = 1024, OFF_F = 2048, OFF_GF = 3072, OFF_Q = 4096, OFF_K = 5120, OFF_GN = 6144, OFF_MERGE = 7168;
constexpr float EPS = 1e-6f;

constexpr size_t SZ_WINT = (size_t)WIN * D * 2, SZ_WPT = (size_t)D * 1024 * 2, SZ_WOT = (size_t)D * D * 2, SZ_WSB = (size_t)8 * 128 * 128 * 2;
constexpr size_t O_WINT = 0;
constexpr size_t O_WPT = O_WINT + SZ_WINT;
constexpr size_t O_WOT = O_WPT + 6 * SZ_WPT;
constexpr size_t O_WSB = O_WOT + 2 * SZ_WOT;
constexpr size_t O_MOD = O_WSB + 2 * SZ_WSB;
constexpr size_t O_DFTC = O_MOD + (size_t)2 * 9 * 6144 * 4;
constexpr size_t O_CSN = O_DFTC + (size_t)512 * 256 * 2;
constexpr size_t O_CSC = O_CSN + (size_t)2048 * 4096 * 2;
constexpr size_t O_H = O_CSC + (size_t)256 * 512 * 2;
constexpr size_t O_TT = O_H;
constexpr size_t O_TTC = O_TT + (size_t)32 * 256 * 4096 * 2;
constexpr size_t O_Y = O_H;
constexpr size_t O_Z = O_H + (size_t)MT * D * 2;
constexpr size_t O_VGT = O_Z + (size_t)MT * ZLD * 2;
constexpr size_t O_VT = O_VGT + (size_t)1024 * MT * 2;
constexpr size_t O_STATS = O_VT + (size_t)1024 * MT * 2;
constexpr size_t O_AB = O_STATS + (size_t)MT * 2 * 4;
constexpr size_t O_FB = O_AB + (size_t)MT * 1024 * 2;
constexpr size_t O_NB = O_FB + (size_t)MT * 1024 * 2;
constexpr size_t O_C1 = O_NB + (size_t)MT * 1024 * 2;
constexpr size_t WS_TOTAL = O_C1 + (size_t)MC * D * 4;
static_assert(WS_TOTAL <= (size_t)1006632960, "workspace budget");
static_assert((size_t)32 * 256 * 4096 * 2 + (size_t)32 * 256 * 512 * 2 <= (size_t)MT * D * 2, "TT alias");

struct Params {
    const float *x, *c, *ctx, *c_ctx, *norm_g, *w_ada, *b_ada, *w_in, *ln_g, *ln_b, *gws, *gbs, *qg, *kg, *rpb, *w_pa, *w_pf, *w_pn, *w_out;
    float* out;
    char* ws;
};

__device__ __forceinline__ unsigned cvt_pk_bf16(float lo, float hi) { unsigned r; asm volatile("v_cvt_pk_bf16_f32 %0, %1, %2" : "=v"(r) : "v"(lo), "v"(hi)); return r; }
__device__ __forceinline__ float bf_lo(unsigned u) { return __uint_as_float(u << 16); }
__device__ __forceinline__ float bf_hi(unsigned u) { return __uint_as_float(u & 0xffff0000u); }
__device__ __forceinline__ float bf2f(bf16_t b) { return __uint_as_float(((unsigned)b) << 16); }
__device__ __forceinline__ float sigmoid_f(float v) { return __builtin_amdgcn_rcpf(1.0f + __expf(-v)); }
__device__ __forceinline__ float silu_f(float v) { return v * sigmoid_f(v); }
__device__ __forceinline__ float gelu_f(float v) { const float u = 1.5957691216f * (v + 0.044715f * v * v * v); return v * sigmoid_f(u); }
template <int ACT> __device__ __forceinline__ float act_f(float v) {
    if (ACT == 1) return gelu_f(v);
    if (ACT == 2) return silu_f(v);
    if (ACT == 3) return sigmoid_f(v);
    return v;
}

constexpr int BM = 256, BK = 64, HALF = 128, HTB = HALF * BK * 2, STAGE_BYTES = 8 * HTB, NXCD = 8, WGM = 8;
__device__ __forceinline__ int lds_byte(int r, int c) { const int st = (r >> 4) * 2 + (c >> 5), rr = r & 15, cc = c & 31, ob = rr * 64 + cc * 2; return st * 1024 + (ob ^ (((ob >> 9) & 1) << 5)); }
__device__ __forceinline__ void stage_rc(int b, int& R, int& C) { const int st = b / 1024, sb = b % 1024, swz = sb ^ (((sb >> 9) & 1) << 5); R = (st >> 1) * 16 + swz / 64; C = (st & 1) * 32 + (swz % 64) / 2; }
__device__ __forceinline__ int perm32(int rho) { const int n = rho >> 4, i = rho & 15; return 8 * (i >> 2) + 4 * n + (i & 3); }

struct Unit { const char* a; const char* b; int pm, pn, kind; };

template <class Epi, class Sched>
__device__ __forceinline__ void gemm_phase(LAS unsigned char* lds, const int lda, const int ldb, const int K, const Sched& S, const Epi& E) {
    int tid_ = threadIdx.x; asm volatile("" : "+v"(tid_));
    const int tid = tid_, wid = __builtin_amdgcn_readfirstlane(tid >> 6), lane = tid & 63, wr = wid >> 2, wc = wid & 3, fr = lane & 15, fq = lane >> 4;
    const int nt = K / BK;
    unsigned voffA[2], voffB[2];
#pragma unroll
    for (int i = 0; i < 2; ++i) { int R, C; stage_rc(tid * 16 + i * 8192, R, C); const int Rb = (R & ~31) + perm32(R & 31);
        voffA[i] = (unsigned)(R * lda + C) * 2u; voffB[i] = (unsigned)(Rb * ldb + C) * 2u; }
    const size_t kstep = (size_t)(BK * 2);
    const size_t hstepA = (size_t)HALF * lda * 2, hstepB = (size_t)HALF * ldb * 2;
    const unsigned ldsw = (unsigned)wid * 1024u;
    const int aoff = lds_byte(wr * 64 + fr, fq * 8), boff = lds_byte(wc * 32 + fr, fq * 8);
#define PG8_SA(b, h) (((b) * 2 + (h)) * HTB)
#define PG8_SB(b, h) ((4 + (b) * 2 + (h)) * HTB)
#define PG8_STAGE(bufoff, gbase, voff) do { _Pragma("unroll") for (int _i = 0; _i < 2; ++_i) \
        __builtin_amdgcn_global_load_lds((const unsigned*)((const char*)(gbase) + (voff)[_i]), (LAS unsigned*)(lds + (bufoff) + ldsw + _i * 8192), 16, 0, 0); } while (0)
#define PG8_LDA(dst, b, h) do { _Pragma("unroll") for (int m = 0; m < 4; ++m) _Pragma("unroll") for (int k = 0; k < 2; ++k) dst[m][k] = *(const LAS bf16x8*)(lds + PG8_SA(b, h) + aoff + m * 2048 + k * 1024); } while (0)
#define PG8_LDB(dst, b, h) do { _Pragma("unroll") for (int n = 0; n < 2; ++n) _Pragma("unroll") for (int k = 0; k < 2; ++k) dst[n][k] = *(const LAS bf16x8*)(lds + PG8_SB(b, h) + boff + n * 2048 + k * 1024); } while (0)
#define PG8_MMA(ai, bj, At, Bt) do { __builtin_amdgcn_s_setprio(1); _Pragma("unroll") for (int m = 0; m < 4; ++m) _Pragma("unroll") for (int n = 0; n < 2; ++n) _Pragma("unroll") for (int k = 0; k < 2; ++k) \
        acc[ai][bj][m][n] = __builtin_amdgcn_mfma_f32_16x16x32_bf16(Bt[n][k], At[m][k], acc[ai][bj][m][n], 0, 0, 0); __builtin_amdgcn_s_setprio(0); } while (0)
#define PG8_WAIT_V(n) asm volatile("s_waitcnt vmcnt(" #n ")" ::: "memory")
#define PG8_WAIT_L(n) asm volatile("s_waitcnt lgkmcnt(" #n ")" ::: "memory")
#define PG8_BAR __builtin_amdgcn_s_barrier()
#define PG8_SCHED __builtin_amdgcn_sched_barrier(0)
    Unit cur, nxt; int ui = 0;
    if (!S.next(0, cur)) return;
    f32x4 acc[2][2][4][2];
#pragma unroll
    for (int a = 0; a < 2; ++a)
#pragma unroll
        for (int b = 0; b < 2; ++b)
#pragma unroll
            for (int m = 0; m < 4; ++m)
#pragma unroll
                for (int n = 0; n < 2; ++n) acc[a][b][m][n] = (f32x4){0.f, 0.f, 0.f, 0.f};
    bf16x8 At[4][2], B0[2][2], B1[2][2];
    const char* cA = cur.a; const char* cB = cur.b;
    PG8_STAGE(PG8_SB(0, 0), cB, voffB); PG8_STAGE(PG8_SA(0, 0), cA, voffA); PG8_STAGE(PG8_SB(0, 1), cB + hstepB, voffB); PG8_STAGE(PG8_SA(0, 1), cA + hstepA, voffA);
    if (wr == 1) PG8_BAR;
    PG8_WAIT_V(4); PG8_BAR;
    PG8_STAGE(PG8_SB(1, 0), cB + kstep, voffB); PG8_STAGE(PG8_SA(1, 0), cA + kstep, voffA); PG8_STAGE(PG8_SB(1, 1), cB + hstepB + kstep, voffB);
    PG8_WAIT_V(6); PG8_BAR;
#pragma unroll 1
    for (;;) {
        const bool has_next = S.next(ui + 1, nxt);
        const char* nA = has_next ? nxt.a : cA; const char* nB = has_next ? nxt.b : cB;
#pragma unroll 1
        for (int t = 0; t < nt; t += 2) {
            const bool last = (t == nt - 2);
            const char* a1 = cA + (size_t)(t + 1) * kstep;
            const char* a2 = last ? nA : cA + (size_t)(t + 2) * kstep; const char* b2 = last ? nB : cB + (size_t)(t + 2) * kstep;
            const char* a3 = a2 + kstep; const char* b3 = b2 + kstep;
            PG8_LDB(B0, 0, 0); PG8_SCHED; PG8_LDA(At, 0, 0); PG8_STAGE(PG8_SA(1, 1), a1 + hstepA, voffA);
            PG8_WAIT_L(8); PG8_BAR; PG8_WAIT_L(0); PG8_MMA(0, 0, At, B0); PG8_BAR; PG8_SCHED;
            PG8_LDB(B1, 0, 1); PG8_STAGE(PG8_SB(0, 0), b2, voffB);
            PG8_BAR; PG8_WAIT_L(0); PG8_MMA(0, 1, At, B1); PG8_BAR;
            PG8_LDA(At, 0, 1); PG8_STAGE(PG8_SA(0, 0), a2, voffA);
            PG8_BAR; PG8_WAIT_L(0); PG8_MMA(1, 0, At, B0); PG8_BAR; PG8_SCHED;
            PG8_STAGE(PG8_SB(0, 1), b2 + hstepB, voffB);
            PG8_WAIT_V(6); PG8_BAR; PG8_MMA(1, 1, At, B1); PG8_BAR;
            PG8_LDB(B0, 1, 0); PG8_SCHED; PG8_LDA(At, 1, 0); PG8_STAGE(PG8_SA(0, 1), a2 + hstepA, voffA);
            PG8_WAIT_L(8); PG8_BAR; PG8_WAIT_L(0); PG8_MMA(0, 0, At, B0); PG8_BAR; PG8_SCHED;
            PG8_LDB(B1, 1, 1); PG8_STAGE(PG8_SB(1, 0), b3, voffB);
            PG8_BAR; PG8_WAIT_L(0); PG8_MMA(0, 1, At, B1); PG8_BAR;
            PG8_LDA(At, 1, 1); PG8_STAGE(PG8_SA(1, 0), a3, voffA);
            PG8_BAR; PG8_WAIT_L(0); PG8_MMA(1, 0, At, B0); PG8_BAR; PG8_SCHED;
            PG8_STAGE(PG8_SB(1, 1), b3 + hstepB, voffB);
            PG8_WAIT_V(6); PG8_BAR; PG8_MMA(1, 1, At, B1); PG8_BAR;
        }
        const bool keep = E(acc, cur, wr, wc, fr, fq);
        if (!has_next) break;
        if (!keep) {
#pragma unroll
            for (int a = 0; a < 2; ++a)
#pragma unroll
                for (int b = 0; b < 2; ++b)
#pragma unroll
                    for (int m = 0; m < 4; ++m)
#pragma unroll
                        for (int n = 0; n < 2; ++n) acc[a][b][m][n] = (f32x4){0.f, 0.f, 0.f, 0.f};
        }
        cur = nxt; cA = nA; cB = nB; ++ui;
    }
    PG8_WAIT_V(0);
    if (wr == 0) PG8_BAR;
    PG8_BAR;
#undef PG8_SA
#undef PG8_SB
#undef PG8_STAGE
#undef PG8_LDA
#undef PG8_LDB
#undef PG8_MMA
#undef PG8_WAIT_V
#undef PG8_WAIT_L
#undef PG8_BAR
#undef PG8_SCHED
}

__device__ __forceinline__ void remap_tile(int L, int nM, int nN, int& pm, int& pn) {
    const int nwg = nM * nN;
    int wgid = L; { const int q = nwg / NXCD, r = nwg % NXCD, xcd = wgid % NXCD, off = wgid / NXCD; wgid = (xcd < r ? xcd * (q + 1) : r * (q + 1) + (xcd - r) * q) + off; }
    const int nig = WGM * nN, gid = wgid / nig, fm = gid * WGM, gsz = (nM - fm) < WGM ? (nM - fm) : WGM;
    pm = fm + ((wgid % nig) % gsz); pn = (wgid % nig) / gsz;
}
struct SchedMain {
    const char* h; const char* wt; int nM, extra, G, c;
    __device__ __forceinline__ bool next(int i, Unit& u) const {
        const int nN = 60, nwg = nM * nN;
        const int L = i * G + c; if (L >= nwg + extra) return false;
        int pm, pn;
        if (L < nwg) {
            int wgid = L; { const int q = nwg / NXCD, r = nwg % NXCD, xcd = wgid % NXCD, off = wgid / NXCD; wgid = (xcd < r ? xcd * (q + 1) : r * (q + 1) + (xcd - r) * q) + off; }
            const int nig = WGM * nN, gid = wgid / nig, fm = gid * WGM, gsz = (nM - fm) < WGM ? (nM - fm) : WGM;
            pm = fm + ((wgid % nig) % gsz); pn = (wgid % nig) / gsz;
        } else { const int e = L - nwg; pm = 64 + (e >> 3); pn = 24 + (e & 7); }
        const bool sw = (pn >= 4 && pn < 8) || (pn >= 28 && pn < 32);
        const char* ap = h + (size_t)pm * (BM * D * 2); const char* bp = wt + (size_t)pn * (BM * D * 2);
        u.a = sw ? bp : ap; u.b = sw ? ap : bp; u.pm = pm; u.pn = pn;
        int kind;
        if (pn < 4) kind = 1; else if (pn < 8) kind = 4; else if (pn < 12) kind = 2; else if (pn < 16) kind = 0; else if (pn < 20) kind = 2;
        else if (pn < 28) kind = 0; else if (pn < 32) kind = 5; else if (pn < 36) kind = 2; else kind = 0;
        u.kind = kind; return true;
    }
};
template <int ACT> __device__ __forceinline__ void store_tile_bf16(const f32x4 (&acc)[2][2][4][2], bf16_t* base  , const size_t ld) {
#pragma unroll
    for (int ai = 0; ai < 2; ++ai)
#pragma unroll
        for (int m = 0; m < 4; ++m) { bf16_t* rowp = base + (size_t)(ai * HALF + m * 16) * ld;
#pragma unroll
            for (int bj = 0; bj < 2; ++bj) { const f32x4 v0 = acc[ai][bj][m][0], v1 = acc[ai][bj][m][1];
                u32x4 w; w.x = cvt_pk_bf16(act_f<ACT>(v0[0]), act_f<ACT>(v0[1])); w.y = cvt_pk_bf16(act_f<ACT>(v0[2]), act_f<ACT>(v0[3]));
                w.z = cvt_pk_bf16(act_f<ACT>(v1[0]), act_f<ACT>(v1[1])); w.w = cvt_pk_bf16(act_f<ACT>(v1[2]), act_f<ACT>(v1[3]));
                *(u32x4*)(rowp + bj * HALF) = w; } }
}
struct EpiMain {
    bf16_t* z; bf16_t* vgT; bf16_t* vT;
    __device__ __forceinline__ bool operator()(const f32x4 (&acc)[2][2][4][2], const Unit& u, int wr, int wc, int fr, int fq) const {
        if (u.kind < 4) {
            bf16_t* base = z + (size_t)(u.pm * BM + wr * 64 + fr) * ZLD + ((u.pn < 4 ? u.pn : u.pn < 28 ? u.pn - 4 : u.pn - 8) * BM + wc * 32 + 8 * fq);
            if (u.kind == 0) store_tile_bf16<0>(acc, base, ZLD);
            else if (u.kind == 1) store_tile_bf16<1>(acc, base, ZLD);
            else if (u.kind == 2) store_tile_bf16<2>(acc, base, ZLD);
            else store_tile_bf16<3>(acc, base, ZLD);
        } else {
            if (u.kind == 4) { bf16_t* base = vgT + (size_t)((u.pn - 4) * BM + wr * 64 + fr) * MT + (u.pm * BM + wc * 32 + 8 * fq); store_tile_bf16<1>(acc, base, MT); }
            else { bf16_t* base = vT + (size_t)((u.pn - 28) * BM + wr * 64 + fr) * MT + (u.pm * BM + wc * 32 + 8 * fq); store_tile_bf16<0>(acc, base, MT); }
        }
        return false;
    }
};

struct SchedF1 {
    const char* dft; const char* z; int nunits, G, c;
    __device__ __forceinline__ bool next(int i, Unit& u) const {
        const int L = i * G + c; if (L >= nunits) return false;
        const int mt = L & 1, g = (L >> 1) & 3, tt = L >> 3;
        u.a = dft + (size_t)mt * (256 * 256 * 2); u.b = z + ((size_t)tt * BM * ZLD + OFF_F + g * 256) * 2; u.pm = mt; u.pn = tt; u.kind = g; return true;
    }
};
struct EpiF1 {
    bf16_t* TT; bf16_t* TTc;
    __device__ __forceinline__ bool operator()(const f32x4 (&acc)[2][2][4][2], const Unit& u, int wr, int wc, int fr, int fq) const {
        const int g = u.kind, cs = u.pm, tt = u.pn;
        const int k0 = wr * 64 + fr, n0 = wc * 32 + 8 * fq;
        bf16_t* base; size_t ld;
        if (tt < 64) { const int b = tt >> 3; base = TT + ((size_t)((b * 4 + g) * 256 + k0)) * 4096 + cs * 2048 + (tt & 7) * 256 + n0; ld = 4096; }
        else { const int b = tt - 64; base = TTc + ((size_t)((b * 4 + g) * 256 + k0)) * 512 + cs * 256 + n0; ld = 512; }
        store_tile_bf16<0>(acc, base, ld);
        return false;
    }
};

struct SchedF2 {
    const char* cs; const char* tt; int nunits, ctxmode, G, c;
    __device__ __forceinline__ bool next(int i, Unit& u) const {
        const int L = i * G + c; if (L >= nunits) return false;
        if (!ctxmode) { const int bg = (L & 7) + 8 * (L >> 6), pt = (L >> 3) & 7; u.a = cs + (size_t)pt * (256 * 4096 * 2); u.b = tt + (size_t)bg * (256 * 4096 * 2); u.pm = pt; u.pn = bg; }
        else { u.a = cs; u.b = tt + (size_t)L * (256 * 512 * 2); u.pm = 0; u.pn = L; }
        u.kind = 0; return true;
    }
};
struct EpiF2 {
    const bf16_t* z; bf16_t* fb; int ctxmode; float scale;
    __device__ __forceinline__ bool operator()(const f32x4 (&acc)[2][2][4][2], const Unit& u, int wr, int wc, int fr, int fq) const {
        const int b = u.pn >> 2, g = u.pn & 3;
        const int row0 = (ctxmode ? ML + b * CTX : b * SEQ + u.pm * BM) + wr * 64 + fr, ch0 = g * 256 + wc * 32 + 8 * fq;
#pragma unroll
        for (int ai = 0; ai < 2; ++ai) {
            u32x4 gq[4][2];
#pragma unroll
            for (int m = 0; m < 4; ++m)
#pragma unroll
                for (int bj = 0; bj < 2; ++bj) gq[m][bj] = *(const u32x4*)(z + (size_t)(row0 + ai * HALF + m * 16) * ZLD + OFF_GF + ch0 + bj * HALF);
#pragma unroll
            for (int m = 0; m < 4; ++m) { const size_t row = (size_t)(row0 + ai * HALF + m * 16);
#pragma unroll
                for (int bj = 0; bj < 2; ++bj) { const f32x4 v0 = acc[ai][bj][m][0] * scale, v1 = acc[ai][bj][m][1] * scale; const u32x4 g = gq[m][bj];
                    u32x4 w; w.x = cvt_pk_bf16(v0[0] * bf_lo(g.x), v0[1] * bf_hi(g.x)); w.y = cvt_pk_bf16(v0[2] * bf_lo(g.y), v0[3] * bf_hi(g.y));
                    w.z = cvt_pk_bf16(v1[0] * bf_lo(g.z), v1[1] * bf_hi(g.z)); w.w = cvt_pk_bf16(v1[2] * bf_lo(g.w), v1[3] * bf_hi(g.w));
                    *(u32x4*)(fb + row * 1024 + ch0 + bj * HALF) = w; } }
            __builtin_amdgcn_sched_barrier(0); }
        return false;
    }
};

struct SchedMerge {
    const char* ab; const char* wp; int ntiles, G, c;
    __device__ __forceinline__ bool next(int i, Unit& u) const {
        const int t = i / 3, br = i - 3 * t; const int L = t * G + c; if (L >= ntiles) return false;
        int pm, pn; remap_tile(L, ntiles >> 3, 8, pm, pn);
        u.a = ab + (size_t)br * ((size_t)MT * 1024 * 2) + (size_t)pm * (BM * 1024 * 2); u.b = wp + (size_t)br * SZ_WPT + (size_t)pn * (BM * 1024 * 2);
        u.pm = pm; u.pn = pn; u.kind = br; return true;
    }
};
struct EpiMerge {
    const bf16_t* z; bf16_t* y;
    __device__ __forceinline__ bool operator()(f32x4 (&acc)[2][2][4][2], const Unit& u, int wr, int wc, int fr, int fq) const {
        const int br = u.kind;
        const int row0 = u.pm * BM + wr * 64 + fr, col0 = u.pn * BM + wc * 32 + 8 * fq;
#pragma unroll
        for (int ai = 0; ai < 2; ++ai) {
            u32x4 g0[4][2], g1[4][2];
#pragma unroll
            for (int m = 0; m < 4; ++m)
#pragma unroll
                for (int bj = 0; bj < 2; ++bj) { const bf16_t* gp = z + (size_t)(row0 + ai * HALF + m * 16) * ZLD + OFF_MERGE + br * D + col0 + bj * HALF;
                    g0[m][bj] = *(const u32x4*)gp; if (br < 2) g1[m][bj] = *(const u32x4*)(gp + D); }
#pragma unroll
            for (int m = 0; m < 4; ++m) { const size_t row = (size_t)(row0 + ai * HALF + m * 16);
#pragma unroll
                for (int bj = 0; bj < 2; ++bj) {
                    const u32x4 ga = g0[m][bj];
                    float f[8] = {bf_lo(ga.x), bf_hi(ga.x), bf_lo(ga.y), bf_hi(ga.y), bf_lo(ga.z), bf_hi(ga.z), bf_lo(ga.w), bf_hi(ga.w)};
#pragma unroll
                    for (int j = 0; j < 8; ++j) f[j] = sigmoid_f(f[j]);
                    if (br < 2) { const u32x4 gb = g1[m][bj];
                        const float d[8] = {bf_lo(gb.x), bf_hi(gb.x), bf_lo(gb.y), bf_hi(gb.y), bf_lo(gb.z), bf_hi(gb.z), bf_lo(gb.w), bf_hi(gb.w)};
#pragma unroll
                        for (int j = 0; j < 8; ++j) f[j] = f[j] * (1.0f + __expf(-d[j]));
                    }
#pragma unroll
                    for (int j = 0; j < 4; ++j) { acc[ai][bj][m][0][j] *= f[j]; acc[ai][bj][m][1][j] *= f[4 + j]; }
                    if (br == 2) { const f32x4 v0 = acc[ai][bj][m][0], v1 = acc[ai][bj][m][1];
                        u32x4 w; w.x = cvt_pk_bf16(v0[0], v0[1]); w.y = cvt_pk_bf16(v0[2], v0[3]); w.z = cvt_pk_bf16(v1[0], v1[1]); w.w = cvt_pk_bf16(v1[2], v1[3]);
                        *(u32x4*)(y + row * D + col0 + bj * HALF) = w; } } }
            __builtin_amdgcn_sched_barrier(0);
        }
        return br < 2;
    }
};

struct SchedOut {
    const char* y; const char* wo; int ntiles, G, c;
    __device__ __forceinline__ bool next(int i, Unit& u) const {
        const int L = i * G + c; if (L >= ntiles) return false;
        int pm, pn; remap_tile(L, ntiles >> 3, 8, pm, pn);
        u.a = y + (size_t)pm * (BM * D * 2); u.b = wo + (size_t)pn * (BM * D * 2); u.pm = pm; u.pn = pn; u.kind = 0; return true;
    }
};
struct EpiOut {
    const float* xin; const float* cin; float* xout; float* cout; const float* mod;
    __device__ __forceinline__ bool operator()(const f32x4 (&acc)[2][2][4][2], const Unit& u, int wr, int wc, int fr, int fq) const {
        const int col0 = u.pn * BM + wc * 32 + 8 * fq;
        const bool isctx = u.pm >= 64;
        const int brow = isctx ? 8 : (u.pm >> 3);
        const float* gate = mod + brow * 6144 + 2 * D + col0;
        const size_t rbase = isctx ? (size_t)(u.pm - 64) * BM : (size_t)u.pm * BM;
        const float* src = (isctx ? cin : xin) + (rbase + wr * 64 + fr) * D + col0;
        float* dst = (isctx ? cout : xout) + (rbase + wr * 64 + fr) * D + col0;
#pragma unroll
        for (int bj = 0; bj < 2; ++bj) { const f32x4 ga = *(const f32x4*)(gate + bj * HALF), gb = *(const f32x4*)(gate + bj * HALF + 4);
#pragma unroll
            for (int ai = 0; ai < 2; ++ai) {
                f32x4 x0[4], x1[4];
#pragma unroll
                for (int m = 0; m < 4; ++m) { const size_t o = (size_t)(ai * HALF + m * 16) * D + bj * HALF; x0[m] = *(const f32x4*)(src + o); x1[m] = *(const f32x4*)(src + o + 4); }
#pragma unroll
                for (int m = 0; m < 4; ++m) { const size_t o = (size_t)(ai * HALF + m * 16) * D + bj * HALF;
                    *(f32x4*)(dst + o) = x0[m] + ga * acc[ai][bj][m][0]; *(f32x4*)(dst + o + 4) = x1[m] + gb * acc[ai][bj][m][1]; }
                __builtin_amdgcn_sched_barrier(0); } }
        return false;
    }
};

__device__ __forceinline__ void transpose_tile(const float* __restrict__ src, bf16_t* __restrict__ dst, int R, int C, int tile, unsigned char* smem) {
    const int nct = C >> 8; const int rt = tile / nct, ct = tile - rt * nct; const int r0 = rt * 64, c0 = ct * 256;
    unsigned* tl = (unsigned*)smem;
    int tid_ = threadIdx.x; asm volatile("" : "+v"(tid_));
    const int tid = tid_;
    f32x4 v[8];
#pragma unroll
    for (int i = 0; i < 8; ++i) { const int idx = tid + i * 512, r = idx >> 6, c4 = (idx & 63) * 4; v[i] = *(const f32x4*)(src + (size_t)(r0 + r) * C + c0 + c4); }
#pragma unroll
    for (int i = 0; i < 8; ++i) { const int idx = tid + i * 512, r = idx >> 6, c4 = (idx & 63) * 4; tl[r * 129 + (c4 >> 1)] = cvt_pk_bf16(v[i][0], v[i][1]); tl[r * 129 + (c4 >> 1) + 1] = cvt_pk_bf16(v[i][2], v[i][3]); }
    __syncthreads();
    const bf16_t* ts = (const bf16_t*)smem;
#pragma unroll
    for (int i = 0; i < 4; ++i) { const int idx = tid + i * 512, c = idx >> 3, r8 = (idx & 7) * 8;
        unsigned short e[8];
#pragma unroll
        for (int j = 0; j < 8; ++j) e[j] = ts[(r8 + j) * 258 + c];
        u32x4 w; w.x = e[0] | ((unsigned)e[1] << 16); w.y = e[2] | ((unsigned)e[3] << 16); w.z = e[4] | ((unsigned)e[5] << 16); w.w = e[6] | ((unsigned)e[7] << 16);
        *(u32x4*)(dst + (size_t)(c0 + c) * R + r0 + r8) = w; }
    __syncthreads();
}

__device__ void phase0(const Params& p, unsigned char* smem) {
    int tid_ = threadIdx.x; asm volatile("" : "+v"(tid_));
    const int tid = tid_, bid = blockIdx.x, G = gridDim.x;
    char* ws = p.ws;
    {
        float* sc = (float*)smem;
        float* red = (float*)(smem + 9 * 2048 * 4);
        bool filled = false;
        for (int task = bid; task < 192; task += G) {
            if (!filled) { for (int i = tid; i < 9 * 2048; i += 512) { const int r = i >> 11, k = i & 2047; const float v = r < 8 ? p.c[r * D + k] : p.c_ctx[k]; sc[i] = silu_f(v); } filled = true; __syncthreads(); }
            const int l = task / 96, jb = task % 96; const int col = tid & 63, part = tid >> 6;
            const float* w = p.w_ada + (size_t)l * D * 6144 + jb * 64 + col;
            float a[9];
#pragma unroll
            for (int r = 0; r < 9; ++r) a[r] = 0.f;
            for (int kk = 0; kk < 256; ++kk) { const int k = part * 256 + kk; const float wv = w[(size_t)k * 6144];
#pragma unroll
                for (int r = 0; r < 9; ++r) a[r] += sc[r * 2048 + k] * wv; }
#pragma unroll
            for (int r = 0; r < 9; ++r) red[(part * 9 + r) * 64 + col] = a[r];
            __syncthreads();
            for (int i = tid; i < 9 * 64; i += 512) { const int r = i >> 6, cc = i & 63; float s = 0.f;
#pragma unroll
                for (int q = 0; q < 8; ++q) s += red[(q * 9 + r) * 64 + cc];
                ((float*)(ws + O_MOD))[(l * 9 + r) * 6144 + jb * 64 + cc] = s + p.b_ada[l * 6144 + jb * 64 + cc]; }
            __syncthreads();
        }
        __syncthreads();
    }
    {
        constexpr int T_IN = (D / 64) * (WIN / 256), T_P = (1024 / 64) * (D / 256), T_O = (D / 64) * (D / 256);
        constexpr int T_TOT = T_IN + 6 * T_P + 2 * T_O;
        for (int task = bid; task < T_TOT; task += G) {
            int t = task;
            if (t < T_IN) { transpose_tile(p.w_in, (bf16_t*)(ws + O_WINT), D, WIN, t, smem); continue; }
            t -= T_IN;
            if (t < 6 * T_P) { const int w = t / T_P; t -= w * T_P; const int l = w / 3, br = w % 3; const float* s = (br == 0 ? p.w_pa : br == 1 ? p.w_pf : p.w_pn) + (size_t)l * 1024 * D;
                transpose_tile(s, (bf16_t*)(ws + O_WPT + (size_t)(l * 3 + br) * SZ_WPT), 1024, D, t, smem); continue; }
            t -= 6 * T_P;
            { const int l = t / T_O; t -= l * T_O; transpose_tile(p.w_out + (size_t)l * D * D, (bf16_t*)(ws + O_WOT + l * SZ_WOT), D, D, t, smem); }
        }
    }
    {
        const size_t gt = (size_t)bid * 512 + tid, gs = (size_t)G * 512;
        bf16_t* wsb = (bf16_t*)(ws + O_WSB);
        for (size_t i = gt; i < (size_t)2 * 8 * 128 * 128 / 2; i += gs) ((unsigned*)wsb)[i] = cvt_pk_bf16(p.gws[2 * i], p.gws[2 * i + 1]);
        unsigned* dftc = (unsigned*)(ws + O_DFTC);
        for (size_t i = gt; i < (size_t)512 * 256 / 2; i += gs) { const int kp = (int)(i >> 7), c = (int)(i & 127) * 2, k = kp & 255; float v[2];
#pragma unroll
            for (int j = 0; j < 2; ++j) { const int ang = (k * (c + j)) & 255; float s, co; sincospif((float)ang * (1.0f / 128.0f), &s, &co); v[j] = kp < 256 ? co : s; }
            dftc[i] = cvt_pk_bf16(v[0], v[1]); }
        unsigned* csn = (unsigned*)(ws + O_CSN);
        for (size_t i = gt; i < (size_t)2048 * 4096 / 2; i += gs) { const int pp = (int)(i >> 11), n2 = (int)(i & 2047) * 2; float v[2];
#pragma unroll
            for (int j = 0; j < 2; ++j) { const int nn = n2 + j, n = nn & 2047; const int ang = (pp * n) & 2047; float s, co; sincospif((float)ang * (1.0f / 1024.0f), &s, &co); v[j] = nn < 2048 ? co : -s; }
            csn[i] = cvt_pk_bf16(v[0], v[1]); }
        unsigned* csc = (unsigned*)(ws + O_CSC);
        for (size_t i = gt; i < (size_t)256 * 512 / 2; i += gs) { const int pp = (int)(i >> 8), n2 = (int)(i & 255) * 2; float v[2];
#pragma unroll
            for (int j = 0; j < 2; ++j) { const int nn = n2 + j, n = nn & 255; const int ang = (pp * n) & 255; float s, co; sincospif((float)ang * (1.0f / 128.0f), &s, &co); v[j] = nn < 256 ? co : -s; }
            csc[i] = cvt_pk_bf16(v[0], v[1]); }
    }
}

__device__ void phase_norm(const Params& p, int l, const float* xin, const float* cin) {
    int tid_ = threadIdx.x; asm volatile("" : "+v"(tid_));
    const int lane = tid_ & 63, gw = blockIdx.x * 8 + (tid_ >> 6), nw = gridDim.x * 8;
    const float* mod = (const float*)(p.ws + O_MOD) + (size_t)l * 9 * 6144;
    const float* ng = p.norm_g + l * D;
    bf16_t* h = (bf16_t*)(p.ws + O_H);
    for (int row = gw; row < MT; row += nw) {
        const float* src = row < ML ? xin + (size_t)row * D : cin + (size_t)(row - ML) * D;
        const int br = row < ML ? (row >> 11) : 8;
        const float* mr = mod + br * 6144;
        f32x4 v[8]; float ss = 0.f;
#pragma unroll
        for (int i = 0; i < 8; ++i) { v[i] = *(const f32x4*)(src + i * 256 + lane * 4); ss += v[i][0] * v[i][0] + v[i][1] * v[i][1] + v[i][2] * v[i][2] + v[i][3] * v[i][3]; }
#pragma unroll
        for (int o = 32; o >= 1; o >>= 1) ss += __shfl_xor(ss, o);
        const float rstd = rsqrtf(ss * (1.0f / D) + EPS);
#pragma unroll
        for (int i = 0; i < 8; ++i) { const int d = i * 256 + lane * 4;
            const f32x4 g = *(const f32x4*)(ng + d), sh = *(const f32x4*)(mr + d), scl = *(const f32x4*)(mr + D + d);
            const f32x4 o = (v[i] * rstd * g) * (scl + 1.0f) + sh;
            u32x2 w; w.x = cvt_pk_bf16(o[0], o[1]); w.y = cvt_pk_bf16(o[2], o[3]);
            *(u32x2*)(h + (size_t)row * D + d) = w; }
    }
}

__device__ void phase_qknorm(const Params& p, int l, int last) {
    int tid_ = threadIdx.x; asm volatile("" : "+v"(tid_));
    const int lane = tid_ & 63, gw = blockIdx.x * 8 + (tid_ >> 6), nw = gridDim.x * 8;
    bf16_t* z = (bf16_t*)(p.ws + O_Z);
    const int ntask = 2 * MT;
    for (int task = gw; task < ntask; task += nw) {
        const int row = task >> 1, isk = task & 1;
        if (last && row >= ML && !isk) continue;
        bf16_t* ptr = z + (size_t)row * ZLD + (isk ? OFF_K : OFF_Q) + lane * 16;
        const float* g = (isk ? p.kg : p.qg) + l * 128 + (lane & 7) * 16;
        const u32x4 a = *(const u32x4*)ptr, b = *(const u32x4*)(ptr + 8);
        float f[16] = {bf_lo(a.x), bf_hi(a.x), bf_lo(a.y), bf_hi(a.y), bf_lo(a.z), bf_hi(a.z), bf_lo(a.w), bf_hi(a.w),
                       bf_lo(b.x), bf_hi(b.x), bf_lo(b.y), bf_hi(b.y), bf_lo(b.z), bf_hi(b.z), bf_lo(b.w), bf_hi(b.w)};
        float ss = 0.f;
#pragma unroll
        for (int j = 0; j < 16; ++j) ss += f[j] * f[j];
        ss += __shfl_xor(ss, 1); ss += __shfl_xor(ss, 2); ss += __shfl_xor(ss, 4);
        float rs = rsqrtf(ss * (1.0f / 128.0f) + EPS);
        if (!isk) rs *= 0.08838834764831845f;
#pragma unroll
        for (int j = 0; j < 16; ++j) f[j] = f[j] * rs * g[j];
        u32x4 oa, ob;
        oa.x = cvt_pk_bf16(f[0], f[1]); oa.y = cvt_pk_bf16(f[2], f[3]); oa.z = cvt_pk_bf16(f[4], f[5]); oa.w = cvt_pk_bf16(f[6], f[7]);
        ob.x = cvt_pk_bf16(f[8], f[9]); ob.y = cvt_pk_bf16(f[10], f[11]); ob.z = cvt_pk_bf16(f[12], f[13]); ob.w = cvt_pk_bf16(f[14], f[15]);
        *(u32x4*)ptr = oa; *(u32x4*)(ptr + 8) = ob;
    }
}
__device__ void phase_lnstats(const Params& p, int ntok, unsigned char* smem) {
    int tid_ = threadIdx.x; asm volatile("" : "+v"(tid_));
    const int tid = tid_, tk = tid & 63, part = tid >> 6;
    const bf16_t* vgT = (const bf16_t*)(p.ws + O_VGT);
    float* stats = (float*)(p.ws + O_STATS);
    float* red = (float*)smem;
    for (int task = blockIdx.x; task < ntok / 64; task += gridDim.x) {
        const int tok = task * 64 + tk; float s = 0.f, q = 0.f;
        const bf16_t* src = vgT + (size_t)(part * 128) * MT + tok;
#pragma unroll 8
        for (int i = 0; i < 128; ++i) { const float v = bf2f(src[(size_t)i * MT]); s += v; q += v * v; }
        red[(part * 64 + tk) * 2] = s; red[(part * 64 + tk) * 2 + 1] = q;
        __syncthreads();
        if (part == 0) { float S = 0.f, Q = 0.f;
#pragma unroll
            for (int j = 0; j < 8; ++j) { S += red[(j * 64 + tk) * 2]; Q += red[(j * 64 + tk) * 2 + 1]; }
            const float mu = S * (1.0f / 1024.0f); const float var = fmaxf(Q * (1.0f / 1024.0f) - mu * mu, 0.f);
            stats[2 * tok] = mu; stats[2 * tok + 1] = rsqrtf(var + EPS); }
        __syncthreads();
    }
}

__device__ __forceinline__ void gmlp_task(const Params& p, int l, int task, int lane) {
    const int fr = lane & 15, fq = lane >> 4;
    const int cblk = task & 7, g = (task >> 3) & 7, ck = task >> 6;
    const int row0 = ck * 128;
    const bf16_t* vgT = (const bf16_t*)(p.ws + O_VGT);
    const float* stats = (const float*)(p.ws + O_STATS);
    const bf16_t* wsb = (const bf16_t*)(p.ws + O_WSB) + (size_t)(l * 8 + g) * 128 * 128;
    const bf16_t* z = (const bf16_t*)(p.ws + O_Z);
    bf16_t* ab = (bf16_t*)(p.ws + O_AB);
    const int ch = g * 128 + cblk * 16 + fr;
    const float lg = p.ln_g[l * 1024 + ch], lb = p.ln_b[l * 1024 + ch];
    bf16x8 af[4];
#pragma unroll
    for (int ks = 0; ks < 4; ++ks) { const int q0 = ks * 32 + fq * 8;
        const u32x4 raw = *(const u32x4*)(vgT + (size_t)ch * MT + row0 + q0);
        const float* st = stats + (size_t)(row0 + q0) * 2;
        const f32x4 s0 = *(const f32x4*)st, s1 = *(const f32x4*)(st + 4), s2 = *(const f32x4*)(st + 8), s3 = *(const f32x4*)(st + 12);
        const float e0 = (bf_lo(raw.x) - s0[0]) * s0[1] * lg + lb, e1 = (bf_hi(raw.x) - s0[2]) * s0[3] * lg + lb;
        const float e2 = (bf_lo(raw.y) - s1[0]) * s1[1] * lg + lb, e3 = (bf_hi(raw.y) - s1[2]) * s1[3] * lg + lb;
        const float e4 = (bf_lo(raw.z) - s2[0]) * s2[1] * lg + lb, e5 = (bf_hi(raw.z) - s2[2]) * s2[3] * lg + lb;
        const float e6 = (bf_lo(raw.w) - s3[0]) * s3[1] * lg + lb, e7 = (bf_hi(raw.w) - s3[2]) * s3[3] * lg + lb;
        u32x4 w; w.x = cvt_pk_bf16(e0, e1); w.y = cvt_pk_bf16(e2, e3); w.z = cvt_pk_bf16(e4, e5); w.w = cvt_pk_bf16(e6, e7);
        af[ks] = __builtin_bit_cast(bf16x8, w); }
    const float* bs = p.gbs + (l * 8 + g) * 128;
#pragma unroll 2
    for (int pb = 0; pb < 8; ++pb) {
        f32x4 acc = {0.f, 0.f, 0.f, 0.f};
#pragma unroll
        for (int ks = 0; ks < 4; ++ks) { const bf16x8 bfr = *(const bf16x8*)(wsb + (size_t)(pb * 16 + fr) * 128 + ks * 32 + fq * 8);
            acc = __builtin_amdgcn_mfma_f32_16x16x32_bf16(af[ks], bfr, acc, 0, 0, 0); }
        const int row = row0 + pb * 16 + fr, cc = g * 128 + cblk * 16 + 4 * fq;
        const float bsv = bs[pb * 16 + fr];
        const u32x2 uu = *(const u32x2*)(z + (size_t)row * ZLD + OFF_U + cc), gg = *(const u32x2*)(z + (size_t)row * ZLD + OFF_GA + cc);
        u32x2 w; w.x = cvt_pk_bf16(bf_lo(uu.x) * (acc[0] + bsv) * bf_lo(gg.x), bf_hi(uu.x) * (acc[1] + bsv) * bf_hi(gg.x));
        w.y = cvt_pk_bf16(bf_lo(uu.y) * (acc[2] + bsv) * bf_lo(gg.y), bf_hi(uu.y) * (acc[3] + bsv) * bf_hi(gg.y));
        *(u32x2*)(ab + (size_t)row * 1024 + cc) = w;
    }
}

__device__ __forceinline__ void attn_task(const Params& p, int l, int task, int ctxq, int lane) {
    const int fr = lane & 15, fq = lane >> 4;
    const bf16_t* z = (const bf16_t*)(p.ws + O_Z);
    const bf16_t* vT = (const bf16_t*)(p.ws + O_VT);
    bf16_t* nb = (bf16_t*)(p.ws + O_NB);
    int b, h, r = 0, j = 0, qrow0;
    if (!ctxq) { j = task & 3; r = (task >> 2) & 31; h = (task >> 7) & 7; b = task >> 10; qrow0 = b * SEQ + r * 64 + j * 16; }
    else { const int qb = task & 15; h = (task >> 4) & 7; b = task >> 7; qrow0 = ML + b * CTX + qb * 16; }
    bf16x8 qf[4];
#pragma unroll
    for (int ks = 0; ks < 4; ++ks) qf[ks] = *(const bf16x8*)(z + (size_t)(qrow0 + fr) * ZLD + OFF_Q + h * 128 + ks * 32 + fq * 8);
    f32x4 o[8];
#pragma unroll
    for (int i = 0; i < 8; ++i) o[i] = (f32x4){0.f, 0.f, 0.f, 0.f};
    float mrun = -INFINITY, lrun = 0.f;
    const int rs = min(max(r - 4, 0), 24), band0 = min(max(j * 16 - 8, 0), 32);
    const int cq = j * 16 + fr, cstart = min(max(cq - 8, 0), 48);
    const float* rpb = p.rpb + (size_t)(l * 8 + h) * 15 * 31;
    const int nloc = ctxq ? 0 : 8;
    const int nsteps = nloc + 8;
    auto krow_of = [&](int step) { return (step < nloc) ? (b * SEQ + (rs + step) * 64 + band0) : (ML + b * CTX + (step - nloc) * 32); };
    const int kperm = 8 * (fr >> 2) + (fr & 3);
    bf16x8 kcur[2][4], knxt[2][4];
    { const int kr0 = krow_of(0);
#pragma unroll
      for (int kb = 0; kb < 2; ++kb)
#pragma unroll
        for (int ks = 0; ks < 4; ++ks) kcur[kb][ks] = *(const bf16x8*)(z + (size_t)(kr0 + kperm + 4 * kb) * ZLD + OFF_K + h * 128 + fq * 8 + ks * 32); }
    for (int step = 0; step < nsteps; ++step) {
        const bool loc = step < nloc;
        const int kr = rs + step;
        const int krow0 = krow_of(step);
        const bf16_t* vp = vT + (size_t)(h * 128 + fr) * MT + krow0 + 8 * fq;
        bf16x8 vv[8];
#pragma unroll
        for (int db = 0; db < 8; ++db) vv[db] = *(const bf16x8*)(vp + (size_t)(db * 16) * MT);
        { const int krn = krow_of(step + 1 < nsteps ? step + 1 : step);
#pragma unroll
          for (int kb = 0; kb < 2; ++kb)
#pragma unroll
            for (int ks = 0; ks < 4; ++ks) knxt[kb][ks] = *(const bf16x8*)(z + (size_t)(krn + kperm + 4 * kb) * ZLD + OFF_K + h * 128 + fq * 8 + ks * 32); }
        f32x4 st[2];
#pragma unroll
        for (int kb = 0; kb < 2; ++kb) { f32x4 a = {0.f, 0.f, 0.f, 0.f};
#pragma unroll
            for (int ks = 0; ks < 4; ++ks) a = __builtin_amdgcn_mfma_f32_16x16x32_bf16(kcur[kb][ks], qf[ks], a, 0, 0, 0);
            st[kb] = a; }
        if (loc) { const int dr = kr - r;
#pragma unroll
            for (int kb = 0; kb < 2; ++kb)
#pragma unroll
                for (int jj = 0; jj < 4; ++jj) { const int ckc = band0 + 8 * fq + 4 * kb + jj; const bool valid = (ckc >= cstart) && (ckc < cstart + 16);
                    const int dc = valid ? (ckc - cq) : 0; const float bias = rpb[(dr + 7) * 31 + dc + 15];
                    st[kb][jj] = valid ? st[kb][jj] + bias : -INFINITY; } }
        float mx = fmaxf(fmaxf(fmaxf(st[0][0], st[0][1]), fmaxf(st[0][2], st[0][3])), fmaxf(fmaxf(st[1][0], st[1][1]), fmaxf(st[1][2], st[1][3])));
        mx = fmaxf(mx, __shfl_xor(mx, 16)); mx = fmaxf(mx, __shfl_xor(mx, 32));
        const float mnew = fmaxf(mrun, mx);
        const float alpha = __expf(mrun - mnew);
        mrun = mnew;
        float pv[8]; float psum = 0.f;
#pragma unroll
        for (int kb = 0; kb < 2; ++kb)
#pragma unroll
            for (int jj = 0; jj < 4; ++jj) { const float e = __expf(st[kb][jj] - mnew); pv[kb * 4 + jj] = e; psum += e; }
        lrun = lrun * alpha + psum;
        u32x4 pw; pw.x = cvt_pk_bf16(pv[0], pv[1]); pw.y = cvt_pk_bf16(pv[2], pv[3]); pw.z = cvt_pk_bf16(pv[4], pv[5]); pw.w = cvt_pk_bf16(pv[6], pv[7]);
        const bf16x8 pf = __builtin_bit_cast(bf16x8, pw);
#pragma unroll
        for (int db = 0; db < 8; ++db) { o[db] = o[db] * alpha;
            o[db] = __builtin_amdgcn_mfma_f32_16x16x32_bf16(vv[db], pf, o[db], 0, 0, 0); }
#pragma unroll
        for (int kb = 0; kb < 2; ++kb)
#pragma unroll
            for (int ks = 0; ks < 4; ++ks) kcur[kb][ks] = knxt[kb][ks];
    }
    lrun += __shfl_xor(lrun, 16); lrun += __shfl_xor(lrun, 32);
    const float inv = 1.0f / lrun;
    const size_t row = (size_t)(qrow0 + fr);
#pragma unroll
    for (int db = 0; db < 8; ++db) { const int cc = h * 128 + db * 16 + 4 * fq;
        const u32x2 gg = *(const u32x2*)(z + row * ZLD + OFF_GN + cc);
        u32x2 w; w.x = cvt_pk_bf16(o[db][0] * inv * bf_lo(gg.x), o[db][1] * inv * bf_hi(gg.x)); w.y = cvt_pk_bf16(o[db][2] * inv * bf_lo(gg.y), o[db][3] * inv * bf_hi(gg.y));
        *(u32x2*)(nb + row * 1024 + cc) = w; }
}

#ifndef PM
#define PM 0xFFFF
#endif
#define XB_CNT(j) (64 * (j))
#define XB_SUB(j) (1024 + 64 * (j))
#define XB_TOP 2048
#define XB_ALL 2112
#define XB_BYTES 16384
__device__ __forceinline__ unsigned xb_ld(unsigned* p) { return __hip_atomic_load(p, __ATOMIC_RELAXED, __HIP_MEMORY_SCOPE_AGENT); }
__device__ __forceinline__ unsigned xb_add(unsigned* p, unsigned v) { return __hip_atomic_fetch_add(p, v, __ATOMIC_RELAXED, __HIP_MEMORY_SCOPE_AGENT); }
__device__ __forceinline__ void grid_barrier(unsigned* bar, unsigned epoch, volatile unsigned* bs) {
    int t_ = threadIdx.x; asm volatile("" : "+v"(t_));
    const int lane = t_ & 63, wave = __builtin_amdgcn_readfirstlane(t_ >> 6);
    asm volatile("s_waitcnt vmcnt(0)" ::: "memory");
    if (lane == 0) atomicAdd((unsigned*)&bs[0], 1u);
    if (wave == 0) {
        bool lastx = false;
        if (lane == 0) { while (bs[0] < 8u * epoch) __builtin_amdgcn_s_sleep(1);
            const unsigned old = xb_add(&bar[XB_SUB(bs[4])], 1u); lastx = (old + 1u == bs[2] * epoch); }
        lastx = __builtin_amdgcn_readfirstlane(lastx ? 1 : 0) != 0;
        if (lastx) {
            __builtin_amdgcn_fence(__ATOMIC_RELEASE, "agent");
            asm volatile("s_waitcnt vmcnt(0)" ::: "memory");
            if (lane == 0) xb_add(&bar[XB_TOP], 1u);
        }
        if (lane == 0) { const unsigned need = bs[3] * epoch; while (xb_ld(&bar[XB_TOP]) < need) __builtin_amdgcn_s_sleep(8); }
        __builtin_amdgcn_fence(__ATOMIC_ACQUIRE, "agent");
        asm volatile("s_waitcnt vmcnt(0)" ::: "memory");
        if (lane == 0) bs[1] = epoch;
    }
    while (bs[1] < epoch) __builtin_amdgcn_s_sleep(4);
    asm volatile("" ::: "memory");
}
__device__ __forceinline__ void grid_barrier_setup(unsigned* bar, volatile unsigned* bs) {
    if (threadIdx.x == 0) {
        const unsigned x = (unsigned)__builtin_amdgcn_s_getreg((3 << 11) | 20) & 0xFu;
        bs[0] = 0u; bs[1] = 0u; bs[4] = x;
        xb_add(&bar[XB_CNT(x)], 1u);
        xb_add(&bar[XB_ALL], 1u);
        while (xb_ld(&bar[XB_ALL]) < gridDim.x) __builtin_amdgcn_s_sleep(8);
        unsigned nx = 0u; for (int j = 0; j < 16; ++j) nx += (xb_ld(&bar[XB_CNT(j)]) != 0u) ? 1u : 0u;
        bs[2] = xb_ld(&bar[XB_CNT(x)]); bs[3] = nx;
    }
    __syncthreads();
}
#define GSYNCN(e) do { grid_barrier((unsigned*)(p.ws + WS_TOTAL), (unsigned)(e), blk_sync); } while (0)
__device__ __forceinline__ void gmlp_task2(const Params& p, int l, int task, int lane) {
    const int fr = lane & 15, fq = lane >> 4;
    const int cb = task & 3, g = (task >> 2) & 7, ck = task >> 5;
    const int row0 = ck * 128;
    const bf16_t* vgT = (const bf16_t*)(p.ws + O_VGT);
    const float* stats = (const float*)(p.ws + O_STATS);
    const bf16_t* wsb = (const bf16_t*)(p.ws + O_WSB) + (size_t)(l * 8 + g) * 128 * 128;
    const bf16_t* z = (const bf16_t*)(p.ws + O_Z);
    bf16_t* ab = (bf16_t*)(p.ws + O_AB);
    const int chb = g * 128 + cb * 32 + 8 * (fr >> 2) + (fr & 3);
    bf16x8 af[2][4];
#pragma unroll
    for (int ks = 0; ks < 4; ++ks) { const int q0 = ks * 32 + fq * 8;
        const float* st = stats + (size_t)(row0 + q0) * 2;
        const f32x4 s0 = *(const f32x4*)st, s1 = *(const f32x4*)(st + 4), s2 = *(const f32x4*)(st + 8), s3 = *(const f32x4*)(st + 12);
#pragma unroll
        for (int kb = 0; kb < 2; ++kb) { const int ch = chb + 4 * kb;
            const float lg = p.ln_g[l * 1024 + ch], lb = p.ln_b[l * 1024 + ch];
            const u32x4 raw = *(const u32x4*)(vgT + (size_t)ch * MT + row0 + q0);
            const float e0 = (bf_lo(raw.x) - s0[0]) * s0[1] * lg + lb, e1 = (bf_hi(raw.x) - s0[2]) * s0[3] * lg + lb;
            const float e2 = (bf_lo(raw.y) - s1[0]) * s1[1] * lg + lb, e3 = (bf_hi(raw.y) - s1[2]) * s1[3] * lg + lb;
            const float e4 = (bf_lo(raw.z) - s2[0]) * s2[1] * lg + lb, e5 = (bf_hi(raw.z) - s2[2]) * s2[3] * lg + lb;
            const float e6 = (bf_lo(raw.w) - s3[0]) * s3[1] * lg + lb, e7 = (bf_hi(raw.w) - s3[2]) * s3[3] * lg + lb;
            u32x4 w; w.x = cvt_pk_bf16(e0, e1); w.y = cvt_pk_bf16(e2, e3); w.z = cvt_pk_bf16(e4, e5); w.w = cvt_pk_bf16(e6, e7);
            af[kb][ks] = __builtin_bit_cast(bf16x8, w); } }
    const float* bs = p.gbs + (l * 8 + g) * 128;
#pragma unroll 2
    for (int pb = 0; pb < 8; ++pb) {
        f32x4 acc0 = {0.f, 0.f, 0.f, 0.f}, acc1 = {0.f, 0.f, 0.f, 0.f};
#pragma unroll
        for (int ks = 0; ks < 4; ++ks) { const bf16x8 bfr = *(const bf16x8*)(wsb + (size_t)(pb * 16 + fr) * 128 + ks * 32 + fq * 8);
            acc0 = __builtin_amdgcn_mfma_f32_16x16x32_bf16(af[0][ks], bfr, acc0, 0, 0, 0);
            acc1 = __builtin_amdgcn_mfma_f32_16x16x32_bf16(af[1][ks], bfr, acc1, 0, 0, 0); }
        const int row = row0 + pb * 16 + fr, cc = g * 128 + cb * 32 + 8 * fq;
        const float bsv = bs[pb * 16 + fr];
        const u32x4 uu = *(const u32x4*)(z + (size_t)row * ZLD + OFF_U + cc), gg = *(const u32x4*)(z + (size_t)row * ZLD + OFF_GA + cc);
        u32x4 w;
        w.x = cvt_pk_bf16(bf_lo(uu.x) * (acc0[0] + bsv) * bf_lo(gg.x), bf_hi(uu.x) * (acc0[1] + bsv) * bf_hi(gg.x));
        w.y = cvt_pk_bf16(bf_lo(uu.y) * (acc0[2] + bsv) * bf_lo(gg.y), bf_hi(uu.y) * (acc0[3] + bsv) * bf_hi(gg.y));
        w.z = cvt_pk_bf16(bf_lo(uu.z) * (acc1[0] + bsv) * bf_lo(gg.z), bf_hi(uu.z) * (acc1[1] + bsv) * bf_hi(gg.z));
        w.w = cvt_pk_bf16(bf_lo(uu.w) * (acc1[2] + bsv) * bf_lo(gg.w), bf_hi(uu.w) * (acc1[3] + bsv) * bf_hi(gg.w));
        *(u32x4*)(ab + (size_t)row * 1024 + cc) = w;
    }
}

__device__ __forceinline__ void attn_task2(const Params& p, int l, int task, int lane) {
    const int fr = lane & 15, fq = lane >> 4;
    const bf16_t* z = (const bf16_t*)(p.ws + O_Z);
    const bf16_t* vT = (const bf16_t*)(p.ws + O_VT);
    bf16_t* nb = (bf16_t*)(p.ws + O_NB);
    const int j = task & 3, rp = (task >> 2) & 15, h = (task >> 6) & 7, b = task >> 9;
    const int r0 = 2 * rp;
    const int qrow0 = b * SEQ + r0 * 64 + j * 16;
    bf16x8 qf[2][4];
#pragma unroll
    for (int qi = 0; qi < 2; ++qi)
#pragma unroll
        for (int ks = 0; ks < 4; ++ks) qf[qi][ks] = *(const bf16x8*)(z + (size_t)(qrow0 + qi * 64 + fr) * ZLD + OFF_Q + h * 128 + ks * 32 + fq * 8);
    f32x4 o[2][8];
#pragma unroll
    for (int qi = 0; qi < 2; ++qi)
#pragma unroll
        for (int i = 0; i < 8; ++i) o[qi][i] = (f32x4){0.f, 0.f, 0.f, 0.f};
    float mrun[2] = {-INFINITY, -INFINITY}, lrun[2] = {0.f, 0.f};
    const int rsA = min(max(r0 - 4, 0), 24), rsB = min(max(r0 - 3, 0), 24);
    const int nloc = rsB + 8 - rsA;
    const int band0 = min(max(j * 16 - 8, 0), 32);
    const int cq = j * 16 + fr, cstart = min(max(cq - 8, 0), 48);
    const float* rpb = p.rpb + (size_t)(l * 8 + h) * 15 * 31;
    const int nsteps = nloc + 8;
    const int kperm = 8 * (fr >> 2) + (fr & 3);
    auto krow_of = [&](int step) { return (step < nloc) ? (b * SEQ + (rsA + step) * 64 + band0) : (ML + b * CTX + (step - nloc) * 32); };
    for (int step = 0; step < nsteps; ++step) {
        const bool loc = step < nloc;
        const int kr = rsA + step;
        const int krow0 = krow_of(step);
        const bf16_t* vp = vT + (size_t)(h * 128 + fr) * MT + krow0 + 8 * fq;
        bf16x8 vv[8];
#pragma unroll
        for (int db = 0; db < 8; ++db) vv[db] = *(const bf16x8*)(vp + (size_t)(db * 16) * MT);
        bf16x8 kcur[2][4];
#pragma unroll
        for (int kb = 0; kb < 2; ++kb)
#pragma unroll
            for (int ks = 0; ks < 4; ++ks) kcur[kb][ks] = *(const bf16x8*)(z + (size_t)(krow0 + kperm + 4 * kb) * ZLD + OFF_K + h * 128 + fq * 8 + ks * 32);
#pragma unroll
        for (int qi = 0; qi < 2; ++qi) {
            const int rsq = qi ? rsB : rsA;
            const bool active = !loc || (kr >= rsq && kr < rsq + 8);
            if (active) {
                f32x4 st[2];
#pragma unroll
                for (int kb = 0; kb < 2; ++kb) { f32x4 a = {0.f, 0.f, 0.f, 0.f};
#pragma unroll
                    for (int ks = 0; ks < 4; ++ks) a = __builtin_amdgcn_mfma_f32_16x16x32_bf16(kcur[kb][ks], qf[qi][ks], a, 0, 0, 0);
                    st[kb] = a; }
                if (loc) { const int dr = kr - (r0 + qi);
#pragma unroll
                    for (int kb = 0; kb < 2; ++kb)
#pragma unroll
                        for (int jj = 0; jj < 4; ++jj) { const int ckc = band0 + 8 * fq + 4 * kb + jj; const bool valid = (ckc >= cstart) && (ckc < cstart + 16);
                            const int dc = valid ? (ckc - cq) : 0; const float bias = rpb[(dr + 7) * 31 + dc + 15];
                            st[kb][jj] = valid ? st[kb][jj] + bias : -INFINITY; } }
                float mx = fmaxf(fmaxf(fmaxf(st[0][0], st[0][1]), fmaxf(st[0][2], st[0][3])), fmaxf(fmaxf(st[1][0], st[1][1]), fmaxf(st[1][2], st[1][3])));
                mx = fmaxf(mx, __shfl_xor(mx, 16)); mx = fmaxf(mx, __shfl_xor(mx, 32));
                const float mnew = fmaxf(mrun[qi], mx);
                const float alpha = __expf(mrun[qi] - mnew);
                mrun[qi] = mnew;
                float pv[8]; float psum = 0.f;
#pragma unroll
                for (int kb = 0; kb < 2; ++kb)
#pragma unroll
                    for (int jj = 0; jj < 4; ++jj) { const float e = __expf(st[kb][jj] - mnew); pv[kb * 4 + jj] = e; psum += e; }
                lrun[qi] = lrun[qi] * alpha + psum;
                u32x4 pw; pw.x = cvt_pk_bf16(pv[0], pv[1]); pw.y = cvt_pk_bf16(pv[2], pv[3]); pw.z = cvt_pk_bf16(pv[4], pv[5]); pw.w = cvt_pk_bf16(pv[6], pv[7]);
                const bf16x8 pf = __builtin_bit_cast(bf16x8, pw);
#pragma unroll
                for (int db = 0; db < 8; ++db) { o[qi][db] = o[qi][db] * alpha;
                    o[qi][db] = __builtin_amdgcn_mfma_f32_16x16x32_bf16(vv[db], pf, o[qi][db], 0, 0, 0); }
            }
        }
    }
#pragma unroll
    for (int qi = 0; qi < 2; ++qi) {
        float lr = lrun[qi]; lr += __shfl_xor(lr, 16); lr += __shfl_xor(lr, 32);
        const float inv = 1.0f / lr;
        const size_t row = (size_t)(qrow0 + qi * 64 + fr);
#pragma unroll
        for (int db = 0; db < 8; ++db) { const int cc = h * 128 + db * 16 + 4 * fq;
            const u32x2 gg = *(const u32x2*)(z + row * ZLD + OFF_GN + cc);
            u32x2 w; w.x = cvt_pk_bf16(o[qi][db][0] * inv * bf_lo(gg.x), o[qi][db][1] * inv * bf_hi(gg.x)); w.y = cvt_pk_bf16(o[qi][db][2] * inv * bf_lo(gg.y), o[qi][db][3] * inv * bf_hi(gg.y));
            *(u32x2*)(nb + row * 1024 + cc) = w; }
    }
}

template <int PH> __device__ __forceinline__ void do_phase(const Params& p, const int l, unsigned char* smem) {
    LAS unsigned char* lds = (LAS unsigned char*)smem;
    const int bid = blockIdx.x, G = gridDim.x;
    char* ws = p.ws;
    const int last = (l == 1);
    const float* xin = last ? (const float*)p.out : p.x;
    const float* cin = last ? (const float*)(ws + O_C1) : p.ctx;
    float* xout = p.out;
    float* cout = (float*)(ws + O_C1);
    if (PH == 0) { phase0(p, smem); }
    if (PH == 1) {
        phase_norm(p, l, xin, cin);
        if (last) { __syncthreads(); for (int t = bid; t < (D / 64) * (WIN / 256); t += G) transpose_tile(p.w_in + (size_t)D * WIN, (bf16_t*)(ws + O_WINT), D, WIN, t, smem); }
    }
    if (PH == 2) {
        SchedMain S; S.h = ws + O_H; S.wt = ws + O_WINT; S.nM = last ? 64 : 72; S.extra = last ? 64 : 0; S.G = G; S.c = bid;
        EpiMain E; E.z = (bf16_t*)(ws + O_Z); E.vgT = (bf16_t*)(ws + O_VGT); E.vT = (bf16_t*)(ws + O_VT);
        gemm_phase(lds, D, D, D, S, E);
    }
    if (PH == 3) {
        { SchedF1 S; S.dft = ws + O_DFTC; S.z = ws + O_Z; S.nunits = (last ? 64 : 72) * 8; S.G = G; S.c = bid;
          EpiF1 E; E.TT = (bf16_t*)(ws + O_TT); E.TTc = (bf16_t*)(ws + O_TTC);
          gemm_phase(lds, 256, ZLD, 256, S, E); }
        phase_qknorm(p, l, last);
        __syncthreads();
        phase_lnstats(p, last ? ML : MT, smem);
    }
    if (PH == 4) {
        { SchedF2 S; S.cs = ws + O_CSN; S.tt = ws + O_TT; S.nunits = 256; S.ctxmode = 0; S.G = G; S.c = bid;
          EpiF2 E; E.z = (const bf16_t*)(ws + O_Z); E.fb = (bf16_t*)(ws + O_FB); E.ctxmode = 0; E.scale = 0.001381067932f;
          gemm_phase(lds, 4096, 4096, 4096, S, E); }
        if (!last) {
            SchedF2 S; S.cs = ws + O_CSC; S.tt = ws + O_TTC; S.nunits = 32; S.ctxmode = 1; S.G = G; S.c = (bid + 128) % G;
            EpiF2 E; E.z = (const bf16_t*)(ws + O_Z); E.fb = (bf16_t*)(ws + O_FB); E.ctxmode = 1; E.scale = 0.00390625f;
            gemm_phase(lds, 512, 512, 512, S, E);
        }
        {
            const int ngm = (last ? ML : MT) / 128 * 32;
            int tid_ = threadIdx.x; asm volatile("" : "+v"(tid_));
            const int lane = tid_ & 63, gw = bid * 8 + __builtin_amdgcn_readfirstlane(tid_ >> 6), nw = G * 8;
            for (int t = gw; t < ngm; t += nw) gmlp_task2(p, l, t, lane);
            for (int t = gw; t < 4096; t += nw) attn_task2(p, l, t, lane);
            if (!last) for (int t = gw; t < 1024; t += nw) attn_task(p, l, t, 1, lane);
        }
    }
    if (PH == 5) {
        SchedMerge S; S.ab = ws + O_AB; S.wp = ws + O_WPT + (size_t)l * 3 * SZ_WPT; S.ntiles = (last ? 64 : 72) * 8; S.G = G; S.c = bid;
        EpiMerge E; E.z = (const bf16_t*)(ws + O_Z); E.y = (bf16_t*)(ws + O_Y);
        gemm_phase(lds, 1024, 1024, 1024, S, E);
    }
    if (PH == 6) {
        SchedOut S; S.y = ws + O_Y; S.wo = ws + O_WOT + (size_t)l * SZ_WOT; S.ntiles = (last ? 64 : 72) * 8; S.G = G; S.c = bid;
        EpiOut E; E.xin = xin; E.cin = cin; E.xout = xout; E.cout = cout; E.mod = (const float*)(ws + O_MOD) + (size_t)l * 9 * 6144;
        gemm_phase(lds, D, D, D, S, E);
    }
}

#ifndef MULTI_LAUNCH
#define MULTI_LAUNCH 0
#endif
#if MULTI_LAUNCH
template <int PH> __global__ void __launch_bounds__(512, 2) k_phase(Params p, int l) {
    __shared__ __attribute__((aligned(16))) unsigned char smem[STAGE_BYTES];
    do_phase<PH>(p, l, smem);
}
#else
__global__ void __launch_bounds__(512, 2) fwd_megakernel(Params p) {
    __shared__ __attribute__((aligned(1024))) unsigned char smem[STAGE_BYTES + 32];
    unsigned* blk_sync = (unsigned*)(smem + STAGE_BYTES);
    cg::grid_group grid = cg::this_grid();
    grid_barrier_setup((unsigned*)(p.ws + WS_TOTAL), blk_sync);
    do_phase<0>(p, 0, smem);
    GSYNCN(1);
#pragma unroll 1
    for (int l = 0; l < 2; ++l) {
        do_phase<1>(p, l, smem); GSYNCN(1 + 6 * l + 1);
        do_phase<2>(p, l, smem); GSYNCN(1 + 6 * l + 2);
        do_phase<3>(p, l, smem); GSYNCN(1 + 6 * l + 3);
        do_phase<4>(p, l, smem); GSYNCN(1 + 6 * l + 4);
        do_phase<5>(p, l, smem); GSYNCN(1 + 6 * l + 5);
        do_phase<6>(p, l, smem); if (l == 0) GSYNCN(1 + 6 * l + 6);
    }
    if (p.ws == nullptr) grid.sync();
}
#endif

extern "C" void kernel_launch(void* const* d_in, const int* in_sizes, int n_in, void* d_out, int out_size, void* d_ws, size_t ws_size, hipStream_t stream) {
    static int grid_blocks = 0;
    if (!grid_blocks) {
        int dev = 0, cus = 0, per_cu = 0;
        hipGetDevice(&dev);
        hipDeviceGetAttribute(&cus, hipDeviceAttributeMultiprocessorCount, dev);
        grid_blocks = cus;
    }
    if (ws_size < WS_TOTAL + XB_BYTES) { fprintf(stderr, "workspace too small: %zu < %zu\n", ws_size, (size_t)WS_TOTAL); return; }
    Params p{};
    const float* const* in = (const float* const*)d_in;
    p.x = in[0]; p.c = in[1]; p.ctx = in[2]; p.c_ctx = in[3]; p.norm_g = in[4]; p.w_ada = in[5]; p.b_ada = in[6]; p.w_in = in[7]; p.ln_g = in[8]; p.ln_b = in[9];
    p.gws = in[10]; p.gbs = in[11]; p.qg = in[12]; p.kg = in[13]; p.rpb = in[14]; p.w_pa = in[15]; p.w_pf = in[16]; p.w_pn = in[17]; p.w_out = in[18];
    p.out = (float*)d_out; p.ws = (char*)d_ws;
#if MULTI_LAUNCH
    const dim3 g(256), b(512);
    k_phase<0><<<g, b, 0, stream>>>(p, 0);
    for (int l = 0; l < 2; ++l) {
        k_phase<1><<<g, b, 0, stream>>>(p, l); k_phase<2><<<g, b, 0, stream>>>(p, l); k_phase<3><<<g, b, 0, stream>>>(p, l);
        k_phase<4><<<g, b, 0, stream>>>(p, l); k_phase<5><<<g, b, 0, stream>>>(p, l); k_phase<6><<<g, b, 0, stream>>>(p, l);
    }
#else
    hipMemsetAsync((char*)d_ws + WS_TOTAL, 0, XB_BYTES, stream);
    void* args[] = {&p};
    hipError_t e = hipLaunchCooperativeKernel((void*)fwd_megakernel, dim3(grid_blocks), dim3(512), args, 0, stream);
    if (e != hipSuccess) fprintf(stderr, "cooperative launch failed: %s (grid %d)\n", hipGetErrorString(e), grid_blocks);
#endif
}
```
